# Optimizing an MI355X kernel written in HIP

```python
import jax, jax.numpy as jnp
from jax import lax
import numpy as np

D_MODEL = 1024
BATCH = 8
SEQ = 8192
DEPTH = 2

GRID_W = 64
CTX_LEN = 256
HEAD_DIM = 64
M_WIDTH = D_MODEL // 4
M_HEADS = M_WIDTH // HEAD_DIM
M_CHUNK = 64
N_DIR = 2
A_WIDTH = D_MODEL // 2
A_HEADS = A_WIDTH // HEAD_DIM
A_KV_HEADS = A_HEADS // 4
A_GROUP = A_HEADS // A_KV_HEADS
WINDOW = 128
Q_BLOCK = 128
ROPE_THETA = 10000.0
C_WIDTH = D_MODEL // 4
CONV_K = 31
MIX_WIDTH = M_WIDTH + A_WIDTH + C_WIDTH
FFN_HIDDEN = ((8 * D_MODEL + 3 * 256 - 1) // (3 * 256)) * 256
IN_SPLITS = (M_WIDTH, M_WIDTH, M_WIDTH, M_WIDTH, N_DIR * 2 * M_HEADS,
             A_WIDTH, A_KV_HEADS * HEAD_DIM, A_KV_HEADS * HEAD_DIM, 2 * C_WIDTH)
IN_COLS = sum(IN_SPLITS)
EPS = 1e-6
NEG_INF = -1e30

kernel_name = 'hybrid_mlstm_swa_conformer_dit'


def rmsnorm(x, g):
    xf = x.astype(jnp.float32)
    y = xf * lax.rsqrt(jnp.mean(xf * xf, axis=-1, keepdims=True) + EPS)
    return (y * g.astype(jnp.float32)).astype(x.dtype)


def modulate(h, shift, scale):
    return h * (1 + scale) + shift


def split_cols(p):
    idx = np.cumsum(IN_SPLITS)[:-1].tolist()
    return jnp.split(p, idx, axis=-1)


def heads(a, n):
    return a.reshape(a.shape[:2] + (n, HEAD_DIM))


def rope_axis(x, pos):
    half = x.shape[-1] // 2
    freqs = ROPE_THETA ** (-jnp.arange(half, dtype=jnp.float32) / half)
    ang = pos.astype(jnp.float32)[:, None] * freqs[None, :]
    cos = jnp.cos(ang)[None, :, None, :]
    sin = jnp.sin(ang)[None, :, None, :]
    xf = x.astype(jnp.float32)
    x1, x2 = xf[..., :half], xf[..., half:]
    return jnp.concatenate([x1 * cos - x2 * sin, x2 * cos + x1 * sin], axis=-1).astype(x.dtype)


def rope_2d(x, rows, cols):
    d = x.shape[-1] // 2
    return jnp.concatenate([rope_axis(x[..., :d], rows), rope_axis(x[..., d:], cols)], axis=-1)


def mlstm_scan(q, k, v, li, lf, state):
    b_, nh, L, dh = q.shape
    nc = L // M_CHUNK

    def chunks(a):
        return jnp.moveaxis(a.reshape(a.shape[:2] + (nc, M_CHUNK) + a.shape[3:]), 2, 0)

    tril = jnp.tril(jnp.ones((M_CHUNK, M_CHUNK), dtype=bool))

    def step(carry, inp):
        C, n, m = carry
        qc, kc, vc, lic, lfc = inp
        bcum = jnp.cumsum(lfc, axis=-1)
        dmat = jnp.where(tril, bcum[..., :, None] - bcum[..., None, :] + lic[..., None, :], -jnp.inf)
        inter = bcum + m[..., None]
        m_t = jnp.maximum(inter, jnp.max(dmat, axis=-1))
        s = jnp.einsum('bhtd,bhsd->bhts', qc, kc) * jnp.exp(dmat - m_t[..., None])
        w = jnp.exp(inter - m_t)
        num = w[..., None] * jnp.einsum('bhed,bhtd->bhte', C, qc) + jnp.einsum('bhts,bhse->bhte', s, vc)
        den = w * jnp.einsum('bhd,bhtd->bht', n, qc) + jnp.sum(s, axis=-1)
        h = num / jnp.maximum(jnp.abs(den), jnp.exp(-m_t))[..., None]
        b_end = bcum[..., -1]
        g = b_end[..., None] - bcum + lic
        m_new = jnp.maximum(b_end + m, jnp.max(g, axis=-1))
        decay = jnp.exp(b_end + m - m_new)
        wg = jnp.exp(g - m_new[..., None])
        C_new = decay[..., None, None] * C + jnp.einsum('bhs,bhse,bhsd->bhed', wg, vc, kc)
        n_new = decay[..., None] * n + jnp.einsum('bhs,bhsd->bhd', wg, kc)
        return (C_new, n_new, m_new), h

    state, h = lax.scan(step, state, tuple(chunks(a) for a in (q, k, v, li, lf)))
    h = jnp.moveaxis(h, 0, 2).reshape(b_, nh, L, dh)
    return h, state


def mlstm_prep(q, k, v, g, gate_bias):
    b_, L = q.shape[0], q.shape[1]

    def to_heads(a):
        return jnp.swapaxes(a.astype(jnp.float32).reshape(b_, L, M_HEADS, HEAD_DIM), 1, 2)

    gg = g.astype(jnp.float32).reshape(b_, L, N_DIR, 2, M_HEADS) + gate_bias.astype(jnp.float32)
    gg = jnp.transpose(gg, (2, 3, 0, 4, 1))
    li = gg[:, 0]
    lf = jax.nn.log_sigmoid(gg[:, 1])
    return to_heads(q), to_heads(k) * HEAD_DIM ** -0.5, to_heads(v), li, lf


def mlstm_bidir(xs, cs):
    qx, kx, vx, lix, lfx = xs
    qc, kc, vc, lic, lfc = cs
    b_ = qx.shape[0]
    zero = (jnp.zeros((b_, M_HEADS, HEAD_DIM, HEAD_DIM), jnp.float32),
            jnp.zeros((b_, M_HEADS, HEAD_DIM), jnp.float32),
            jnp.zeros((b_, M_HEADS), jnp.float32))
    hx, hc = None, None
    for d in range(N_DIR):
        fl = (lambda a: jnp.flip(a, axis=2)) if d == 1 else (lambda a: a)
        h_c, st = mlstm_scan(fl(qc), fl(kc), fl(vc), fl(lic[d]), fl(lfc[d]), zero)
        h_x, _ = mlstm_scan(fl(qx), fl(kx), fl(vx), fl(lix[d]), fl(lfx[d]), st)
        hx = fl(h_x) if hx is None else hx + fl(h_x)
        hc = fl(h_c) if hc is None else hc + fl(h_c)
    return hx, hc


def mlstm_out(h, o, gain):
    hn = h * lax.rsqrt(jnp.mean(h * h, axis=-1, keepdims=True) + EPS)
    b_, nh, L, dh = h.shape
    hn = jnp.swapaxes(hn, 1, 2).reshape(b_, L, nh * dh)
    return (hn * gain.astype(jnp.float32) * jax.nn.sigmoid(o.astype(jnp.float32))).astype(o.dtype)


def window_attention(q, k, v, kc, vc, sink):
    b_, S, H, dh = q.shape
    n_ctx = kc.shape[1]
    nb = S // Q_BLOCK
    span = Q_BLOCK + 2 * WINDOW
    pad = ((0, 0), (WINDOW, WINDOW), (0, 0), (0, 0))
    kp = jnp.pad(k, pad)
    vp = jnp.pad(v, pad)
    qg = q.reshape(b_, S, A_KV_HEADS, A_GROUP, dh)
    sink_g = sink.astype(jnp.float32).reshape(A_KV_HEADS, A_GROUP)[None, :, :, None, None]
    scale = dh ** -0.5

    def block(i):
        start = i * Q_BLOCK
        qb = lax.dynamic_slice_in_dim(qg, start, Q_BLOCK, axis=1)
        kb = lax.dynamic_slice_in_dim(kp, start, span, axis=1)
        vb = lax.dynamic_slice_in_dim(vp, start, span, axis=1)
        qpos = start + jnp.arange(Q_BLOCK)
        kpos = start - WINDOW + jnp.arange(span)
        mask = (jnp.abs(qpos[:, None] - kpos[None, :]) <= WINDOW) & (kpos >= 0)[None, :] & (kpos < S)[None, :]
        s_loc = jnp.einsum('bqhgd,bnhd->bhgqn', qb, kb).astype(jnp.float32) * scale
        s_loc = jnp.where(mask, s_loc, NEG_INF)
        s_ctx = jnp.einsum('bqhgd,bchd->bhgqc', qb, kc).astype(jnp.float32) * scale
        s_sink = jnp.broadcast_to(sink_g, s_ctx.shape[:-1] + (1,))
        p = jax.nn.softmax(jnp.concatenate([s_loc, s_ctx, s_sink], axis=-1), axis=-1).astype(v.dtype)
        o = (jnp.einsum('bhgqn,bnhd->bqhgd', p[..., :span], vb)
             + jnp.einsum('bhgqc,bchd->bqhgd', p[..., span:span + n_ctx], vc))
        return o.reshape(b_, Q_BLOCK, H * dh)

    out = lax.map(block, jnp.arange(nb))
    return jnp.moveaxis(out, 0, 1).reshape(b_, S, H * dh)


def context_attention(q, kc, vc, sink):
    b_, n_ctx, H, dh = q.shape
    qg = q.reshape(b_, n_ctx, A_KV_HEADS, A_GROUP, dh)
    s = jnp.einsum('bqhgd,bchd->bhgqc', qg, kc).astype(jnp.float32) * dh ** -0.5
    sink_g = sink.astype(jnp.float32).reshape(A_KV_HEADS, A_GROUP)[None, :, :, None, None]
    s_sink = jnp.broadcast_to(sink_g, s.shape[:-1] + (1,))
    p = jax.nn.softmax(jnp.concatenate([s, s_sink], axis=-1), axis=-1).astype(vc.dtype)
    o = jnp.einsum('bhgqc,bchd->bqhgd', p[..., :n_ctx], vc)
    return o.reshape(b_, n_ctx, H * dh)


def conformer_conv(u, dw_w, dw_b, ln_g, ln_b, pw_w):
    a, gate = jnp.split(u, 2, axis=-1)
    y = a * jax.nn.sigmoid(gate)
    y = lax.conv_general_dilated(y, dw_w[:, None, :].astype(y.dtype), window_strides=(1,),
                                 padding=[(CONV_K // 2, CONV_K // 2)],
                                 dimension_numbers=('NWC', 'WIO', 'NWC'),
                                 feature_group_count=C_WIDTH) + dw_b
    yf = y.astype(jnp.float32)
    mu = jnp.mean(yf, axis=-1, keepdims=True)
    var = jnp.mean(jnp.square(yf - mu), axis=-1, keepdims=True)
    y = ((yf - mu) * lax.rsqrt(var + EPS) * ln_g.astype(jnp.float32) + ln_b.astype(jnp.float32)).astype(u.dtype)
    return jax.nn.silu(y) @ pw_w


def swiglu(h, w_in, w_out):
    g, u = jnp.split(h @ w_in, 2, axis=-1)
    return (jax.nn.silu(g) * u) @ w_out


def setup_inputs(seed: int = 0) -> dict:
    key = jax.random.key(seed)
    ks = jax.random.split(key, 21)

    def nrm(k, shape, s):
        return jax.random.normal(k, shape, jnp.float32) * s

    x = nrm(ks[0], (BATCH, SEQ, D_MODEL), 1.0)
    c = nrm(ks[1], (BATCH, D_MODEL), 1.0)
    ctx = nrm(ks[2], (BATCH, CTX_LEN, D_MODEL), 1.0)
    c_ctx = nrm(ks[3], (D_MODEL,), 1.0)
    w_mod = nrm(ks[4], (DEPTH, D_MODEL, 6 * D_MODEL), 0.5 * D_MODEL ** -0.5)
    b_mod = nrm(ks[5], (DEPTH, 6 * D_MODEL), 0.02)
    norm_gain = 1.0 + nrm(ks[6], (DEPTH, 2, D_MODEL), 0.02)
    w_in = nrm(ks[7], (DEPTH, D_MODEL, IN_COLS), D_MODEL ** -0.5)
    i_bias = nrm(ks[8], (DEPTH, N_DIR, M_HEADS), 0.1)
    f_bias = jnp.linspace(3.0, 6.0, M_HEADS, dtype=jnp.float32) + nrm(ks[9], (DEPTH, N_DIR, M_HEADS), 0.1)
    mlstm_gate_bias = jnp.stack([i_bias, f_bias], axis=2)
    mlstm_head_gain = 1.0 + nrm(ks[10], (DEPTH, M_WIDTH), 0.02)
    attn_sink = nrm(ks[11], (DEPTH, A_HEADS), 0.5)
    conv_dw_w = nrm(ks[12], (DEPTH, CONV_K, C_WIDTH), CONV_K ** -0.5)
    conv_dw_b = nrm(ks[13], (DEPTH, C_WIDTH), 0.02)
    conv_ln_g = 1.0 + nrm(ks[14], (DEPTH, C_WIDTH), 0.02)
    conv_ln_b = nrm(ks[15], (DEPTH, C_WIDTH), 0.02)
    conv_pw_w = nrm(ks[16], (DEPTH, C_WIDTH, C_WIDTH), C_WIDTH ** -0.5)
    w_out = nrm(ks[17], (DEPTH, MIX_WIDTH, D_MODEL), MIX_WIDTH ** -0.5)
    w_ffn_in = nrm(ks[18], (DEPTH, D_MODEL, 2 * FFN_HIDDEN), D_MODEL ** -0.5)
    w_ffn_out = nrm(ks[19], (DEPTH, FFN_HIDDEN, D_MODEL), FFN_HIDDEN ** -0.5)
    final_gain = 1.0 + nrm(ks[20], (D_MODEL,), 0.02)
    return {'x': x, 'c': c, 'ctx': ctx, 'c_ctx': c_ctx, 'w_mod': w_mod, 'b_mod': b_mod,
            'norm_gain': norm_gain, 'w_in': w_in, 'mlstm_gate_bias': mlstm_gate_bias,
            'mlstm_head_gain': mlstm_head_gain, 'attn_sink': attn_sink, 'conv_dw_w': conv_dw_w,
            'conv_dw_b': conv_dw_b, 'conv_ln_g': conv_ln_g, 'conv_ln_b': conv_ln_b,
            'conv_pw_w': conv_pw_w, 'w_out': w_out, 'w_ffn_in': w_ffn_in, 'w_ffn_out': w_ffn_out,
            'final_gain': final_gain}


def reference(x, c, ctx, c_ctx, w_mod, b_mod, norm_gain, w_in, mlstm_gate_bias, mlstm_head_gain,
              attn_sink, conv_dw_w, conv_dw_b, conv_ln_g, conv_ln_b, conv_pw_w, w_out, w_ffn_in,
              w_ffn_out, final_gain):
    S = x.shape[1]
    n_rows = S // GRID_W
    rows = jnp.repeat(jnp.arange(n_rows), GRID_W, total_repeat_length=S)
    cols = jnp.arange(S) % GRID_W
    for l in range(DEPTH):
        last = l == DEPTH - 1
        mod_x = (jax.nn.silu(c) @ w_mod[l] + b_mod[l])[:, None, :]
        sh1x, sc1x, g1x, sh2x, sc2x, g2x = jnp.split(mod_x, 6, axis=-1)
        mod_c = jax.nn.silu(c_ctx) @ w_mod[l] + b_mod[l]
        sh1c, sc1c, g1c, sh2c, sc2c, g2c = jnp.split(mod_c, 6, axis=-1)

        hx = modulate(rmsnorm(x, norm_gain[l, 0]), sh1x, sc1x)
        hc = modulate(rmsnorm(ctx, norm_gain[l, 0]), sh1c, sc1c)
        px = split_cols(hx @ w_in[l])
        pc = split_cols(hc @ w_in[l])

        m_hx, m_hc = mlstm_bidir(mlstm_prep(px[0], px[1], px[2], px[4], mlstm_gate_bias[l]),
                                 mlstm_prep(pc[0], pc[1], pc[2], pc[4], mlstm_gate_bias[l]))
        m_x = mlstm_out(m_hx, px[3], mlstm_head_gain[l])

        q_x = rope_2d(heads(px[5], A_HEADS), rows, cols)
        k_x = rope_2d(heads(px[6], A_KV_HEADS), rows, cols)
        v_x = heads(px[7], A_KV_HEADS)
        k_c = heads(pc[6], A_KV_HEADS)
        v_c = heads(pc[7], A_KV_HEADS)
        a_x = window_attention(q_x, k_x, v_x, k_c, v_c, attn_sink[l])

        c_x = conformer_conv(px[8], conv_dw_w[l], conv_dw_b[l], conv_ln_g[l], conv_ln_b[l], conv_pw_w[l])

        x = x + g1x * (jnp.concatenate([m_x, a_x, c_x], axis=-1) @ w_out[l])
        x = x + g2x * swiglu(modulate(rmsnorm(x, norm_gain[l, 1]), sh2x, sc2x), w_ffn_in[l], w_ffn_out[l])

        if not last:
            m_c = mlstm_out(m_hc, pc[3], mlstm_head_gain[l])
            a_c = context_attention(heads(pc[5], A_HEADS), k_c, v_c, attn_sink[l])
            c_c = conformer_conv(pc[8], conv_dw_w[l], conv_dw_b[l], conv_ln_g[l], conv_ln_b[l], conv_pw_w[l])
            ctx = ctx + g1c * (jnp.concatenate([m_c, a_c, c_c], axis=-1) @ w_out[l])
            ctx = ctx + g2c * swiglu(modulate(rmsnorm(ctx, norm_gain[l, 1]), sh2c, sc2c), w_ffn_in[l], w_ffn_out[l])
    return rmsnorm(x, final_gain)
```

```cpp
#include <hip/hip_runtime.h>
#include <hip/hip_cooperative_groups.h>
#include <cstdio>
#include <cstdint>
namespace cg = cooperative_groups;

#define DI __device__ __forceinline__
typedef __attribute__((ext_vector_type(8))) short bf16x8;
typedef __attribute__((ext_vector_type(16))) float f32x16;
#define MFMA(a, b, c) __builtin_amdgcn_mfma_f32_32x32x16_bf16((a), (b), (c), 0, 0, 0)

constexpr int DM = 1024;
constexpr int NB = 8;
constexpr int SEQ = 8192;
constexpr int CTXL = 256;
constexpr int NLAT = NB * SEQ;
constexpr int NCTX = NB * CTXL;
constexpr int NTOK = NLAT + NCTX;
constexpr int INC = 2320;
constexpr int NP = 2432;
constexpr int PSTR = 2304;
constexpr int FFN = 2816;
constexpr int FFN2 = 5632;
constexpr int C_MQ = 0, C_MK = 256, C_MV = 512, C_MO = 768, C_AQ = 1024, C_AK = 1536, C_AV = 1664, C_CV = 1792;
constexpr float EPS = 1e-6f;

constexpr size_t al256(size_t v) { return (v + 255) & ~(size_t)255; }
constexpr size_t O_WTIN = 0;
constexpr size_t O_WTOUT = O_WTIN + al256((size_t)2 * NP * 1024 * 2);
constexpr size_t O_WTF1 = O_WTOUT + al256((size_t)2 * 1024 * 1024 * 2);
constexpr size_t O_WTF2 = O_WTF1 + al256((size_t)2 * FFN2 * 1024 * 2);
constexpr size_t O_MODV = O_WTF2 + al256((size_t)2 * 1024 * FFN * 2);
constexpr size_t O_SHW1 = O_MODV + al256((size_t)2 * 6 * 9 * 1024 * 4);
constexpr size_t O_SHW2 = O_SHW1 + al256((size_t)2 * 9 * NP * 4);
constexpr size_t O_ROPE = O_SHW2 + al256((size_t)2 * 9 * FFN2 * 4);
constexpr size_t O_CTR = O_ROPE + al256((size_t)128 * 16 * 2 * 4);
constexpr size_t O_BAR = O_CTR + 256;
constexpr size_t O_CTXA = O_BAR + 16384;
constexpr size_t O_MIX = O_CTXA + al256((size_t)NCTX * 1024 * 4);
constexpr size_t O_P = O_MIX + al256((size_t)NTOK * 1024 * 2);
constexpr size_t O_MKT = O_P + al256((size_t)NTOK * PSTR * 2);
constexpr size_t O_MVT = O_MKT + al256((size_t)256 * NTOK * 2);
constexpr size_t O_AVT = O_MVT + al256((size_t)256 * NTOK * 2);
constexpr size_t O_GATES = O_AVT + al256((size_t)128 * NTOK * 2);
constexpr size_t O_HDIR = O_GATES + al256((size_t)NTOK * 16 * 4);
constexpr size_t O_END = O_HDIR + al256((size_t)2 * NTOK * 256 * 2);
constexpr size_t O_HID = O_P;
static_assert(O_HID + (size_t)NTOK * FFN * 2 <= O_END, "hid alias overflow");

struct Params {
    const float *x, *c, *ctx, *c_ctx, *w_mod, *b_mod, *norm_gain, *w_in, *gate_bias, *head_gain, *sink,
        *dw_w, *dw_b, *ln_g, *ln_b, *pw_w, *w_out, *w_ffn_in, *w_ffn_out, *final_gain;
    float* out;
    char* ws;
};
struct WS {
    char* b;
    DI unsigned short* WtIn() const { return (unsigned short*)(b + O_WTIN); }
    DI unsigned short* WtOut() const { return (unsigned short*)(b + O_WTOUT); }
    DI unsigned short* WtF1() const { return (unsigned short*)(b + O_WTF1); }
    DI unsigned short* WtF2() const { return (unsigned short*)(b + O_WTF2); }
    DI float* modv() const { return (float*)(b + O_MODV); }
    DI float* shW1() const { return (float*)(b + O_SHW1); }
    DI float* shW2() const { return (float*)(b + O_SHW2); }
    DI float* rope() const { return (float*)(b + O_ROPE); }
    DI unsigned* ctr() const { return (unsigned*)(b + O_CTR); }
    DI float* ctxa() const { return (float*)(b + O_CTXA); }
    DI unsigned short* mix() const { return (unsigned short*)(b + O_MIX); }
    DI unsigned short* P() const { return (unsigned short*)(b + O_P); }
    DI unsigned short* MKT() const { return (unsigned short*)(b + O_MKT); }
    DI unsigned short* MVT() const { return (unsigned short*)(b + O_MVT); }
    DI unsigned short* AVT() const { return (unsigned short*)(b + O_AVT); }
    DI float* gates() const { return (float*)(b + O_GATES); }
    DI unsigned short* hdir() const { return (unsigned short*)(b + O_HDIR); }
    DI unsigned short* hid() const { return (unsigned short*)(b + O_HID); }
};

DI int opaque_tid(int wv) { int t = wv * 64 + (int)__builtin_amdgcn_mbcnt_hi(~0u, __builtin_amdgcn_mbcnt_lo(~0u, 0u)); asm volatile("" : "+v"(t)); return t; }
DI int opaque_s(int v) { asm volatile("" : "+s"(v)); return v; }
DI unsigned cvtpk(float lo, float hi) { unsigned r; asm("v_cvt_pk_bf16_f32 %0, %1, %2" : "=v"(r) : "v"(lo), "v"(hi)); return r; }
DI float bflo(unsigned u) { return __uint_as_float(u << 16); }
DI float bfhi(unsigned u) { return __uint_as_float(u & 0xffff0000u); }
DI float bf2f(short s) { return __uint_as_float(((unsigned)(unsigned short)s) << 16); }
DI int lds_off(int row, int chunk) { return row * 128 + ((chunk ^ ((row >> 1) & 7)) << 4); }
DI int lds_off8(int row, int k) { return row * 128 + ((((k >> 3)) ^ ((row >> 1) & 7)) << 4) + ((k & 7) << 1); }
DI bf16x8 lds_frag(const char* base, int row, int chunk) { return *(const bf16x8*)(base + lds_off(row, chunk)); }
DI bf16x8 u4_to_frag(uint4 v) { return __builtin_bit_cast(bf16x8, v); }
DI float silu_f(float v) { return v / (1.f + __expf(-v)); }
DI float sigmoid_f(float v) { return 1.f / (1.f + __expf(-v)); }

template <bool F32ACT>
DI void gemm_core(const int wv, char* smem, const unsigned short* __restrict__ Wt, const int K, const int n0,
                  const void* __restrict__ actbase, const int actstride, const float* __restrict__ Gv,
                  f32x16 (&acc)[2][2]) {
    const int tid = opaque_tid(wv), lane = tid & 63, w = tid >> 6, wn = w >> 1, wm = w & 1, g = lane >> 5, lr = lane & 31;
    const int lrow = tid >> 3, lch = tid & 7;
    char* Ws = smem;
    char* Xs = smem + 32768;
    uint4 wreg[4];
    uint4 xreg[4];
    float4 xf0[4], xf1[4];
    float4 gv0, gv1;
    float ss[4] = {0.f, 0.f, 0.f, 0.f};
#pragma unroll
    for (int a = 0; a < 2; ++a)
#pragma unroll
        for (int b = 0; b < 2; ++b)
#pragma unroll
            for (int r = 0; r < 16; ++r) acc[a][b][r] = 0.f;

    const char* wbase = (const char*)(Wt + (size_t)n0 * K);
    const unsigned woff = (unsigned)(lrow * K + lch * 8) * 2u;
    const unsigned wstep = (unsigned)(32 * K) * 2u;
    const char* abase = (const char*)actbase;
    const unsigned aoff = F32ACT ? (unsigned)(lrow * 1024 + lch * 8) * 4u : (unsigned)(lrow * actstride + lch * 8) * 2u;
    const unsigned astep = F32ACT ? 32u * 1024u * 4u : (unsigned)(32 * actstride) * 2u;
    const int KT = K >> 6;

    auto gload = [&](int kt) {
        const char* wb_ = wbase + kt * 128;
#pragma unroll
        for (int i = 0; i < 4; ++i) wreg[i] = *(const uint4*)(wb_ + (woff + i * wstep));
        if (F32ACT) {
            const char* ab_ = abase + kt * 256;
#pragma unroll
            for (int i = 0; i < 4; ++i) {
                xf0[i] = *(const float4*)(ab_ + (aoff + i * astep));
                xf1[i] = *(const float4*)(ab_ + (aoff + i * astep) + 16);
            }
            gv0 = *(const float4*)(Gv + kt * 64 + lch * 8);
            gv1 = *(const float4*)(Gv + kt * 64 + lch * 8 + 4);
        } else {
            const char* ab_ = abase + kt * 128;
#pragma unroll
            for (int i = 0; i < 4; ++i) xreg[i] = *(const uint4*)(ab_ + (aoff + i * astep));
        }
    };
    auto sstore = [&](int buf) {
#pragma unroll
        for (int i = 0; i < 4; ++i) *(uint4*)(Ws + buf * 16384 + lds_off(lrow + 32 * i, lch)) = wreg[i];
        if (F32ACT) {
#pragma unroll
            for (int i = 0; i < 4; ++i) {
                float4 a = xf0[i], b = xf1[i];
                ss[i] += a.x * a.x + a.y * a.y + a.z * a.z + a.w * a.w + b.x * b.x + b.y * b.y + b.z * b.z + b.w * b.w;
                uint4 v;
                v.x = cvtpk(a.x * gv0.x, a.y * gv0.y);
                v.y = cvtpk(a.z * gv0.z, a.w * gv0.w);
                v.z = cvtpk(b.x * gv1.x, b.y * gv1.y);
                v.w = cvtpk(b.z * gv1.z, b.w * gv1.w);
                *(uint4*)(Xs + buf * 16384 + lds_off(lrow + 32 * i, lch)) = v;
            }
        } else {
#pragma unroll
            for (int i = 0; i < 4; ++i) *(uint4*)(Xs + buf * 16384 + lds_off(lrow + 32 * i, lch)) = xreg[i];
        }
    };

    __syncthreads();
    gload(0);
    sstore(0);
    __syncthreads();
    for (int kt = 0; kt < KT; ++kt) {
        const int buf = kt & 1;
        if (kt + 1 < KT) gload(kt + 1);
        const char* wb = Ws + buf * 16384;
        const char* xb = Xs + buf * 16384;
#pragma unroll
        for (int ks = 0; ks < 4; ++ks) {
            bf16x8 wf0 = lds_frag(wb, wn * 64 + lr, ks * 2 + g);
            bf16x8 wf1 = lds_frag(wb, wn * 64 + 32 + lr, ks * 2 + g);
            bf16x8 xa = lds_frag(xb, wm * 64 + lr, ks * 2 + g);
            bf16x8 xb1 = lds_frag(xb, wm * 64 + 32 + lr, ks * 2 + g);
            acc[0][0] = MFMA(wf0, xa, acc[0][0]);
            acc[0][1] = MFMA(wf0, xb1, acc[0][1]);
            acc[1][0] = MFMA(wf1, xa, acc[1][0]);
            acc[1][1] = MFMA(wf1, xb1, acc[1][1]);
        }
        if (kt + 1 < KT) sstore(buf ^ 1);
        __syncthreads();
    }
    if (F32ACT) {
        float* rs = (float*)smem;
#pragma unroll
        for (int i = 0; i < 4; ++i) {
            float s = ss[i];
            s += __shfl_xor(s, 1);
            s += __shfl_xor(s, 2);
            s += __shfl_xor(s, 4);
            if (lch == 0) rs[lrow + 32 * i] = rsqrtf(s * (1.f / 1024.f) + EPS);
        }
        __syncthreads();
    }
}

DI void p0_mod(const int wv, const Params& p, int item, char* smem) {
    const int l = item / 96, cb = item % 96;
    const int tid = opaque_tid(wv);
    float* s_l = (float*)smem;
    float* red = s_l + 9 * 1024;
    __syncthreads();
    for (int i = tid; i < 9 * 1024; i += 256) {
        int bb = i >> 10, k = i & 1023;
        float v = bb < 8 ? p.c[bb * 1024 + k] : p.c_ctx[k];
        s_l[i] = v / (1.f + expf(-v));
    }
    __syncthreads();
    const int col = cb * 64 + (tid & 63), kg = tid >> 6;
    float acc[9];
#pragma unroll
    for (int bb = 0; bb < 9; ++bb) acc[bb] = 0.f;
    const float* wp = p.w_mod + (size_t)l * 1024 * 6144 + col;
#pragma unroll 8
    for (int k = kg * 256; k < kg * 256 + 256; ++k) {
        float wv = wp[(size_t)k * 6144];
#pragma unroll
        for (int bb = 0; bb < 9; ++bb) acc[bb] += s_l[bb * 1024 + k] * wv;
    }
#pragma unroll
    for (int bb = 0; bb < 9; ++bb) red[(kg * 9 + bb) * 64 + (tid & 63)] = acc[bb];
    __syncthreads();
    for (int i = tid; i < 9 * 64; i += 256) {
        int bb = i >> 6, cc = i & 63;
        int cg_ = cb * 64 + cc;
        float v = red[(0 * 9 + bb) * 64 + cc] + red[(1 * 9 + bb) * 64 + cc] + red[(2 * 9 + bb) * 64 + cc] + red[(3 * 9 + bb) * 64 + cc];
        v += p.b_mod[l * 6144 + cg_];
        int sec = cg_ >> 10, k = cg_ & 1023;
        if (sec == 1) v = p.norm_gain[(l * 2 + 0) * 1024 + k] * (1.f + v);
        if (sec == 4) v = p.norm_gain[(l * 2 + 1) * 1024 + k] * (1.f + v);
        WS{p.ws}.modv()[((size_t)(l * 6 + sec) * 9 + bb) * 1024 + k] = v;
    }
}

DI void p0_convert(const int wv, const Params& p, int mode, int l, int kt, int nt, char* smem) {
    float* tile = (float*)smem;
    const int tid = opaque_tid(wv);
    const float* src;
    unsigned short* dst;
    int srcN, K;
    if (mode == 0) { src = p.w_in + (size_t)l * 1024 * INC; srcN = INC; K = 1024; dst = WS{p.ws}.WtIn() + (size_t)l * NP * 1024; }
    else if (mode == 1) { src = p.w_out + (size_t)l * 1024 * 1024; srcN = 1024; K = 1024; dst = WS{p.ws}.WtOut() + (size_t)l * 1024 * 1024; }
    else if (mode == 2) { src = p.w_ffn_in + (size_t)l * 1024 * FFN2; srcN = FFN2; K = 1024; dst = WS{p.ws}.WtF1() + (size_t)l * FFN2 * 1024; }
    else { src = p.w_ffn_out + (size_t)l * FFN * 1024; srcN = 1024; K = FFN; dst = WS{p.ws}.WtF2() + (size_t)l * 1024 * FFN; }
    __syncthreads();
    {
        const int c4 = (tid & 15) * 4;
        const int n = nt * 64 + c4;
        int sc;
        if (mode == 0) sc = n < 1024 ? n : (n < 2304 ? n + 16 : (n < 2320 ? n - 1280 : -1));
        else if (mode == 2) { int jb = n >> 6, wi = n & 63; sc = jb * 32 + (wi & 31) + (wi >= 32 ? FFN : 0); }
        else sc = n;
#pragma unroll
        for (int i = 0; i < 4; ++i) {
            const int kk = (tid >> 4) + 16 * i;
            float4 v = make_float4(0.f, 0.f, 0.f, 0.f);
            if (sc >= 0) v = *(const float4*)(src + (size_t)(kt * 64 + kk) * srcN + sc);
            tile[kk * 65 + c4 + 0] = v.x; tile[kk * 65 + c4 + 1] = v.y; tile[kk * 65 + c4 + 2] = v.z; tile[kk * 65 + c4 + 3] = v.w;
        }
    }
    __syncthreads();
    {
        const int n = tid >> 2, k0 = (tid & 3) * 16;
        unsigned o[8];
#pragma unroll
        for (int q = 0; q < 8; ++q) o[q] = cvtpk(tile[(k0 + 2 * q) * 65 + n], tile[(k0 + 2 * q + 1) * 65 + n]);
        unsigned short* d = dst + (size_t)(nt * 64 + n) * K + kt * 64 + k0;
        *(uint4*)d = make_uint4(o[0], o[1], o[2], o[3]);
        *(uint4*)(d + 8) = make_uint4(o[4], o[5], o[6], o[7]);
    }
}

DI void p0_fold(const int wv, const Params& p, int l, int kt, int nt, char* smem) {
    float* pwS = (float*)smem;
    float* woS = pwS + 64 * 65;
    const int tid = opaque_tid(wv), n = tid & 63, kg = tid >> 6;
    float acc[16];
#pragma unroll
    for (int i = 0; i < 16; ++i) acc[i] = 0.f;
    for (int jc = 0; jc < 4; ++jc) {
        __syncthreads();
        for (int i = tid; i < 64 * 64; i += 256) {
            int r = i >> 6, cc = i & 63;
            pwS[r * 65 + cc] = p.pw_w[(size_t)l * 65536 + (kt * 64 + r) * 256 + jc * 64 + cc];
            woS[r * 64 + cc] = p.w_out[(size_t)l * 1024 * 1024 + (size_t)(768 + jc * 64 + r) * 1024 + nt * 64 + cc];
        }
        __syncthreads();
        for (int j = 0; j < 64; ++j) {
            float wo = woS[j * 64 + n];
#pragma unroll
            for (int i = 0; i < 16; ++i) acc[i] += pwS[(kg * 16 + i) * 65 + j] * wo;
        }
    }
    unsigned o[8];
#pragma unroll
    for (int q = 0; q < 8; ++q) o[q] = cvtpk(acc[2 * q], acc[2 * q + 1]);
    unsigned short* d = WS{p.ws}.WtOut() + (size_t)l * 1024 * 1024 + (size_t)(nt * 64 + n) * 1024 + 768 + kt * 64 + kg * 16;
    *(uint4*)d = make_uint4(o[0], o[1], o[2], o[3]);
    *(uint4*)(d + 8) = make_uint4(o[4], o[5], o[6], o[7]);
}

DI void phase0a(const int wv, const Params& p, char* smem) {
    const int N_MOD = 192;
    const int N_C0 = 2 * 16 * 38;
    const int N_C1 = 2 * 12 * 16;
    const int N_C2 = 2 * 16 * 88;
    const int N_C3 = 2 * 44 * 16;
    const int N_FOLD = 2 * 4 * 16;
    const int total = N_MOD + N_C0 + N_C1 + N_C2 + N_C3 + N_FOLD + 1;
    for (int it = blockIdx.x; it < total; it += gridDim.x) {
        int i = it;
        if (i < N_MOD) { p0_mod(wv, p, i, smem); continue; }
        i -= N_MOD;
        if (i < N_C0) { int l = i / (16 * 38), r = i % (16 * 38); p0_convert(wv, p, 0, l, r / 38, r % 38, smem); continue; }
        i -= N_C0;
        if (i < N_C1) { int l = i / (12 * 16), r = i % (12 * 16); p0_convert(wv, p, 1, l, r / 16, r % 16, smem); continue; }
        i -= N_C1;
        if (i < N_C2) { int l = i / (16 * 88), r = i % (16 * 88); p0_convert(wv, p, 2, l, r / 88, r % 88, smem); continue; }
        i -= N_C2;
        if (i < N_C3) { int l = i / (44 * 16), r = i % (44 * 16); p0_convert(wv, p, 3, l, r / 16, r % 16, smem); continue; }
        i -= N_C3;
        if (i < N_FOLD) { int l = i / 64, r = i % 64; p0_fold(wv, p, l, r / 16, r % 16, smem); continue; }
        const int tid_m = opaque_tid(wv);
        for (int e = tid_m; e < 128 * 16; e += 256) {
            int pos = e >> 4, f = e & 15;
            float freq = powf(10000.f, -(float)f / 16.f);
            float ang = (float)pos * freq;
            WS{p.ws}.rope()[e * 2 + 0] = cosf(ang);
            WS{p.ws}.rope()[e * 2 + 1] = sinf(ang);
        }
        if (tid_m < 64) WS{p.ws}.ctr()[tid_m] = 0u;
    }
}

DI void phase0c(const int wv, const Params& p, char* smem) {
    float* shs = (float*)smem;
    const int tid = opaque_tid(wv), lane = tid & 63, w = tid >> 6;
    const int total = 2 * (38 + 88);
    for (int it = blockIdx.x; it < total; it += gridDim.x) {
        const int l = it / 126, r = it % 126;
        const bool second = r >= 38;
        const int nb = second ? r - 38 : r;
        const float* shsrc = WS{p.ws}.modv() + (size_t)((l * 6 + (second ? 3 : 0)) * 9) * 1024;
        const unsigned short* Wt = second ? WS{p.ws}.WtF1() + (size_t)l * FFN2 * 1024 : WS{p.ws}.WtIn() + (size_t)l * NP * 1024;
        float* dst = second ? WS{p.ws}.shW2() + (size_t)l * 9 * FFN2 : WS{p.ws}.shW1() + (size_t)l * 9 * NP;
        const int NN = second ? FFN2 : NP;
        __syncthreads();
        for (int i = tid; i < 9 * 1024; i += 256) shs[i] = shsrc[i];
        __syncthreads();
        for (int q = 0; q < 16; ++q) {
            const int n = nb * 64 + w * 16 + q;
            const unsigned short* wr = Wt + (size_t)n * 1024 + lane * 16;
            uint4 a = *(const uint4*)wr, b = *(const uint4*)(wr + 8);
            float wv[16];
            wv[0] = bflo(a.x); wv[1] = bfhi(a.x); wv[2] = bflo(a.y); wv[3] = bfhi(a.y);
            wv[4] = bflo(a.z); wv[5] = bfhi(a.z); wv[6] = bflo(a.w); wv[7] = bfhi(a.w);
            wv[8] = bflo(b.x); wv[9] = bfhi(b.x); wv[10] = bflo(b.y); wv[11] = bfhi(b.y);
            wv[12] = bflo(b.z); wv[13] = bfhi(b.z); wv[14] = bflo(b.w); wv[15] = bfhi(b.w);
#pragma unroll
            for (int bb = 0; bb < 9; ++bb) {
                float s = 0.f;
#pragma unroll
                for (int e = 0; e < 16; ++e) s += wv[e] * shs[bb * 1024 + lane * 16 + e];
#pragma unroll
                for (int o = 32; o >= 1; o >>= 1) s += __shfl_xor(s, o);
                if (lane == 0) dst[(size_t)bb * NN + n] = s;
            }
        }
    }
}

DI void phase_inproj(const int wv, const Params& p, const int l, char* smem) {
    const int tid = opaque_tid(wv), lane = tid & 63, w = tid >> 6, wn = w >> 1, wm = w & 1, g = lane >> 5, lr = lane & 31;
    const int NT = 19, MT = NTOK / 128;
    const unsigned short* Wt = WS{p.ws}.WtIn() + (size_t)l * NP * 1024;
    for (int tile = blockIdx.x; tile < MT * NT; tile += gridDim.x) {
        const int mt = tile / NT, nt = tile % NT;
        const int r0 = mt * 128, n0 = nt * 128;
        const int bb = r0 < NLAT ? (r0 >> 13) : 8;
        const float* xsrc;
        if (l == 0) xsrc = r0 < NLAT ? p.x + (size_t)r0 * 1024 : p.ctx + (size_t)(r0 - NLAT) * 1024;
        else xsrc = r0 < NLAT ? p.out + (size_t)r0 * 1024 : WS{p.ws}.ctxa() + (size_t)(r0 - NLAT) * 1024;
        const float* Gv = WS{p.ws}.modv() + (size_t)((l * 6 + 1) * 9 + bb) * 1024;
        f32x16 acc[2][2];
        gemm_core<true>(wv, smem, Wt, 1024, n0, xsrc, 1024, Gv, acc);
        const float* rs = (const float*)smem;
        const float* sh = WS{p.ws}.shW1() + (size_t)(l * 9 + bb) * NP;
#pragma unroll
        for (int mi = 0; mi < 2; ++mi) {
            const int tokl = wm * 64 + mi * 32 + lr;
            const int r = r0 + tokl;
            const float rstd = rs[tokl];
#pragma unroll
            for (int ni = 0; ni < 2; ++ni) {
                const int nbase = n0 + wn * 64 + ni * 32;
                float v[16];
#pragma unroll
                for (int j = 0; j < 4; ++j) {
                    float4 s4 = *(const float4*)(sh + nbase + 8 * j + 4 * g);
                    v[4 * j + 0] = rstd * acc[ni][mi][4 * j + 0] + s4.x;
                    v[4 * j + 1] = rstd * acc[ni][mi][4 * j + 1] + s4.y;
                    v[4 * j + 2] = rstd * acc[ni][mi][4 * j + 2] + s4.z;
                    v[4 * j + 3] = rstd * acc[ni][mi][4 * j + 3] + s4.w;
                }
                if (nt == 18) {
                    if (wn == 0 && ni == 0) {
#pragma unroll
                        for (int j = 0; j < 2; ++j)
                            *(float4*)(WS{p.ws}.gates() + (size_t)r * 16 + 8 * j + 4 * g) = make_float4(v[4 * j], v[4 * j + 1], v[4 * j + 2], v[4 * j + 3]);
                    }
                    continue;
                }
                const bool is_aq = (nt >= 8 && nt <= 11), is_ak = (nt == 12);
                if ((is_aq || is_ak) && r < NLAT) {
                    const int t = r & (SEQ - 1);
                    const int pos = (ni == 0) ? (t >> 6) : (t & 63);
#pragma unroll
                    for (int jj = 0; jj < 2; ++jj) {
                        const float4 cs0 = *(const float4*)(WS{p.ws}.rope() + (size_t)(pos * 16 + 8 * jj + 4 * g) * 2);
                        const float4 cs1 = *(const float4*)(WS{p.ws}.rope() + (size_t)(pos * 16 + 8 * jj + 4 * g) * 2 + 4);
                        const float cc[4] = {cs0.x, cs0.z, cs1.x, cs1.z};
                        const float sn[4] = {cs0.y, cs0.w, cs1.y, cs1.w};
#pragma unroll
                        for (int i = 0; i < 4; ++i) {
                            const float x1 = v[4 * jj + i], x2 = v[4 * (jj + 2) + i];
                            v[4 * jj + i] = x1 * cc[i] - x2 * sn[i];
                            v[4 * (jj + 2) + i] = x2 * cc[i] + x1 * sn[i];
                        }
                    }
                }
                if (is_aq || nt == 2 || nt == 3) {
#pragma unroll
                    for (int q = 0; q < 16; ++q) v[q] *= 0.125f;
                }
                const bool tr = (nt >= 2 && nt <= 5) || nt == 13;
                const bool rm = !((nt == 4) || (nt == 5) || (nt == 13));
                if (rm) {
#pragma unroll
                    for (int j = 0; j < 4; ++j) {
                        uint2 o;
                        o.x = cvtpk(v[4 * j], v[4 * j + 1]);
                        o.y = cvtpk(v[4 * j + 2], v[4 * j + 3]);
                        *(uint2*)(WS{p.ws}.P() + (size_t)r * PSTR + nbase + 8 * j + 4 * g) = o;
                    }
                }
                if (tr) {
                    unsigned short* T;
                    int nb2;
                    if (nt <= 3) { T = WS{p.ws}.MKT(); nb2 = nbase - C_MK; }
                    else if (nt <= 5) { T = WS{p.ws}.MVT(); nb2 = nbase - C_MV; }
                    else { T = WS{p.ws}.AVT(); nb2 = nbase - C_AV; }
#pragma unroll
                    for (int q = 0; q < 16; ++q) {
                        const int nn = nb2 + (q & 3) + 8 * (q >> 2) + 4 * g;
                        T[(size_t)nn * NTOK + r] = (unsigned short)(cvtpk(v[q], 0.f) & 0xffffu);
                    }
                }
            }
        }
    }
}

template <int WHICH>
DI void phase_resid(const int wv, const Params& p, const int l, char* smem) {
    const int tid = opaque_tid(wv), lane = tid & 63, w = tid >> 6, wn = w >> 1, wm = w & 1, g = lane >> 5, lr = lane & 31;
    const int NT = 8;
    const int MT = (l == 0) ? NTOK / 128 : NLAT / 128;
    const int K = WHICH == 0 ? 1024 : FFN;
    const unsigned short* Wt = WHICH == 0 ? WS{p.ws}.WtOut() + (size_t)l * 1024 * 1024 : WS{p.ws}.WtF2() + (size_t)l * 1024 * FFN;
    const unsigned short* act = WHICH == 0 ? WS{p.ws}.mix() : WS{p.ws}.hid();
    for (int tile = blockIdx.x; tile < MT * NT; tile += gridDim.x) {
        const int mt = tile / NT, nt = tile % NT;
        const int r0 = mt * 128, n0 = nt * 128;
        const int bb = r0 < NLAT ? (r0 >> 13) : 8;
        f32x16 acc[2][2];
        gemm_core<false>(wv, smem, Wt, K, n0, act + (size_t)r0 * K, K, nullptr, acc);
        const float* gate = WS{p.ws}.modv() + (size_t)((l * 6 + (WHICH == 0 ? 2 : 5)) * 9 + bb) * 1024;
        const float* xold;
        float* xnew;
        if (r0 < NLAT) {
            xnew = p.out + (size_t)r0 * 1024;
            xold = (WHICH == 0 && l == 0) ? p.x + (size_t)r0 * 1024 : xnew;
        } else {
            xnew = WS{p.ws}.ctxa() + (size_t)(r0 - NLAT) * 1024;
            xold = (WHICH == 0 && l == 0) ? p.ctx + (size_t)(r0 - NLAT) * 1024 : xnew;
        }
#pragma unroll
        for (int mi = 0; mi < 2; ++mi) {
            const int tokl = wm * 64 + mi * 32 + lr;
#pragma unroll
            for (int ni = 0; ni < 2; ++ni) {
#pragma unroll
                for (int j = 0; j < 4; ++j) {
                    const int n = n0 + wn * 64 + ni * 32 + 8 * j + 4 * g;
                    const float4 gt = *(const float4*)(gate + n);
                    const float4 xo = *(const float4*)(xold + (size_t)tokl * 1024 + n);
                    float4 o;
                    o.x = xo.x + gt.x * acc[ni][mi][4 * j + 0];
                    o.y = xo.y + gt.y * acc[ni][mi][4 * j + 1];
                    o.z = xo.z + gt.z * acc[ni][mi][4 * j + 2];
                    o.w = xo.w + gt.w * acc[ni][mi][4 * j + 3];
                    *(float4*)(xnew + (size_t)tokl * 1024 + n) = o;
                }
            }
        }
    }
}

DI void phase_ffnin(const int wv, const Params& p, const int l, char* smem) {
    const int tid = opaque_tid(wv), lane = tid & 63, w = tid >> 6, wn = w >> 1, wm = w & 1, g = lane >> 5, lr = lane & 31;
    const int NT = 44;
    const int MT = (l == 0) ? NTOK / 128 : NLAT / 128;
    const unsigned short* Wt = WS{p.ws}.WtF1() + (size_t)l * FFN2 * 1024;
    for (int tile = blockIdx.x; tile < MT * NT; tile += gridDim.x) {
        const int mt = tile / NT, nt = tile % NT;
        const int r0 = mt * 128, n0 = nt * 128;
        const int bb = r0 < NLAT ? (r0 >> 13) : 8;
        const float* xsrc = r0 < NLAT ? p.out + (size_t)r0 * 1024 : WS{p.ws}.ctxa() + (size_t)(r0 - NLAT) * 1024;
        const float* Gv = WS{p.ws}.modv() + (size_t)((l * 6 + 4) * 9 + bb) * 1024;
        f32x16 acc[2][2];
        gemm_core<true>(wv, smem, Wt, 1024, n0, xsrc, 1024, Gv, acc);
        const float* rs = (const float*)smem;
        const float* sh = WS{p.ws}.shW2() + (size_t)(l * 9 + bb) * FFN2;
        const int nb = n0 + wn * 64;
        const int jb = nb >> 6;
#pragma unroll
        for (int mi = 0; mi < 2; ++mi) {
            const int tokl = wm * 64 + mi * 32 + lr;
            const int r = r0 + tokl;
            const float rstd = rs[tokl];
#pragma unroll
            for (int j = 0; j < 4; ++j) {
                const float4 sg = *(const float4*)(sh + nb + 8 * j + 4 * g);
                const float4 su = *(const float4*)(sh + nb + 32 + 8 * j + 4 * g);
                float h[4];
                const float sgv[4] = {sg.x, sg.y, sg.z, sg.w};
                const float suv[4] = {su.x, su.y, su.z, su.w};
#pragma unroll
                for (int i = 0; i < 4; ++i) {
                    const float gg = rstd * acc[0][mi][4 * j + i] + sgv[i];
                    const float uu = rstd * acc[1][mi][4 * j + i] + suv[i];
                    h[i] = silu_f(gg) * uu;
                }
                uint2 o;
                o.x = cvtpk(h[0], h[1]);
                o.y = cvtpk(h[2], h[3]);
                *(uint2*)(WS{p.ws}.hid() + (size_t)r * FFN + jb * 32 + 8 * j + 4 * g) = o;
            }
        }
    }
}

DI float scan_sum(float v, int lane, int dir) {
#pragma unroll
    for (int d = 1; d < 64; d <<= 1) {
        float o = dir ? __shfl_down(v, d) : __shfl_up(v, d);
        bool ok = dir ? (lane + d < 64) : (lane >= d);
        if (ok) v += o;
    }
    return v;
}
DI float scan_max(float v, int lane, int dir) {
#pragma unroll
    for (int d = 1; d < 64; d <<= 1) {
        float o = dir ? __shfl_down(v, d) : __shfl_up(v, d);
        bool ok = dir ? (lane + d < 64) : (lane >= d);
        if (ok) v = fmaxf(v, o);
    }
    return v;
}

DI void mlstm_chain(const int wv, const Params& p, const int l_, const int chain, char* smem) {
    const int l = opaque_s(l_);
    const int tid = opaque_tid(wv), lane = tid & 63, w = tid >> 6, g = lane >> 5, lr = lane & 31;
    const int tb = w >> 1, eb = w & 1;
    const int dir = chain & 1, head = (chain >> 1) & 3, b = chain >> 3;
    char* Qs = smem;
    char* Ks = smem + 8192;
    char* KTs = smem + 16384;
    char* VTs = smem + 24576;
    char* Cs = smem + 32768;
    float* a_s = (float*)(smem + 49152);
    float* wg_s = a_s + 64;
    float* n_s = a_s + 128;
    const int lrow = tid >> 3, lch = tid & 7;
    __syncthreads();
    *(uint4*)(Cs + tid * 32) = make_uint4(0, 0, 0, 0);
    *(uint4*)(Cs + tid * 32 + 16) = make_uint4(0, 0, 0, 0);
    if (tid < 128) n_s[tid] = 0.f;
    f32x16 CT;
#pragma unroll
    for (int r = 0; r < 16; ++r) CT[r] = 0.f;
    float m = 0.f;
    const float bias_i = p.gate_bias[l * 16 + dir * 8 + head];
    const float bias_f = p.gate_bias[l * 16 + dir * 8 + 4 + head];
    uint4 rq0, rq1, rk0, rk1, rkt0, rkt1, rvt0, rvt1;
    float gi, gf;
#define CHAIN_ROWBASE(step_) ((step_) < 4 ? (NLAT + b * CTXL + (dir ? 3 - (step_) : (step_)) * 64) : (b * SEQ + (dir ? 127 - ((step_) - 4) : (step_) - 4) * 64))
#define CHAIN_PREFETCH(step_)                                                                              \
    {                                                                                                      \
        const int pr0 = CHAIN_ROWBASE(step_);                                                              \
        const unsigned short* pq = WS{p.ws}.P() + (size_t)(pr0 + lrow) * PSTR + head * 64 + lch * 8;                \
        rq0 = *(const uint4*)(pq + C_MQ);                                                                  \
        rq1 = *(const uint4*)(pq + C_MQ + (size_t)32 * PSTR);                                              \
        rk0 = *(const uint4*)(pq + C_MK);                                                                  \
        rk1 = *(const uint4*)(pq + C_MK + (size_t)32 * PSTR);                                              \
        const size_t to = (size_t)(head * 64 + lrow) * NTOK + pr0 + lch * 8;                               \
        rkt0 = *(const uint4*)(WS{p.ws}.MKT() + to);                                                                \
        rkt1 = *(const uint4*)(WS{p.ws}.MKT() + to + (size_t)32 * NTOK);                                            \
        rvt0 = *(const uint4*)(WS{p.ws}.MVT() + to);                                                                \
        rvt1 = *(const uint4*)(WS{p.ws}.MVT() + to + (size_t)32 * NTOK);                                            \
        gi = WS{p.ws}.gates()[(size_t)(pr0 + lane) * 16 + dir * 8 + head];                                          \
        gf = WS{p.ws}.gates()[(size_t)(pr0 + lane) * 16 + dir * 8 + 4 + head];                                      \
    }
    CHAIN_PREFETCH(0);
    for (int step = 0; step < 132; ++step) {
        const int cur = step & 1, nxt = cur ^ 1;
        const int r0 = CHAIN_ROWBASE(step);
        __syncthreads();
        {
            const int o0 = lds_off(lrow, lch), o1 = lds_off(lrow + 32, lch);
            *(uint4*)(Qs + o0) = rq0; *(uint4*)(Qs + o1) = rq1;
            *(uint4*)(Ks + o0) = rk0; *(uint4*)(Ks + o1) = rk1;
            *(uint4*)(KTs + o0) = rkt0; *(uint4*)(KTs + o1) = rkt1;
            *(uint4*)(VTs + o0) = rvt0; *(uint4*)(VTs + o1) = rvt1;
        }
        const float li = gi + bias_i;
        const float xfg = gf + bias_f;
        const float lf = fminf(xfg, 0.f) - log1pf(expf(-fabsf(xfg)));
        if (step + 1 < 132) CHAIN_PREFETCH(step + 1);
        const float bc = scan_sum(lf, lane, dir);
        const float a = li - bc;
        const float pm = scan_max(a, lane, dir);
        const float b_end = __shfl(bc, dir ? 0 : 63);
        const float pmall = __shfl(pm, dir ? 0 : 63);
        const float mm = fmaxf(m, pm);
        const float M = fmaxf(m, pmall);
        const float decay = expf(m - M);
        const float wgv = expf(a - M);
        if (w == 0) { a_s[lane] = a; wg_s[lane] = wgv; }
        const float m_new = b_end + M;
        const int tl = tb * 32 + lr;
        const float mm_t = __shfl(mm, tl);
        const float bc_t = __shfl(bc, tl);
        const float w_t = expf(m - mm_t);
        const float einv_t = expf(-(bc_t + mm_t));
        __syncthreads();

        bf16x8 qf[4];
#pragma unroll
        for (int ks = 0; ks < 4; ++ks) qf[ks] = lds_frag(Qs, tl, ks * 2 + g);
        f32x16 sT[2], itv;
#pragma unroll
        for (int r = 0; r < 16; ++r) { sT[0][r] = 0.f; sT[1][r] = 0.f; itv[r] = 0.f; }
#pragma unroll
        for (int ks = 0; ks < 4; ++ks) {
            sT[0] = MFMA(lds_frag(Ks, lr, ks * 2 + g), qf[ks], sT[0]);
            sT[1] = MFMA(lds_frag(Ks, 32 + lr, ks * 2 + g), qf[ks], sT[1]);
            itv = MFMA(lds_frag(Cs + cur * 8192, eb * 32 + lr, ks * 2 + g), qf[ks], itv);
        }
        float qn = 0.f;
        {
            const float* ncur = n_s + cur * 64;
#pragma unroll
            for (int ks = 0; ks < 4; ++ks) {
                const float4 n0v = *(const float4*)(ncur + ks * 16 + g * 8);
                const float4 n1v = *(const float4*)(ncur + ks * 16 + g * 8 + 4);
                qn += bf2f(qf[ks][0]) * n0v.x + bf2f(qf[ks][1]) * n0v.y + bf2f(qf[ks][2]) * n0v.z + bf2f(qf[ks][3]) * n0v.w;
                qn += bf2f(qf[ks][4]) * n1v.x + bf2f(qf[ks][5]) * n1v.y + bf2f(qf[ks][6]) * n1v.z + bf2f(qf[ks][7]) * n1v.w;
            }
            qn += __shfl_xor(qn, 32);
        }
        float cs = 0.f;
        f32x16 num;
#pragma unroll
        for (int r = 0; r < 16; ++r) num[r] = itv[r] * w_t;
#pragma unroll
        for (int sb = 0; sb < 2; ++sb) {
#pragma unroll
            for (int hh = 0; hh < 2; ++hh) {
                uint4 pu;
                {
                    const int s0 = sb * 32 + 16 * hh + 4 * g;
                    const float4 av = *(const float4*)(a_s + s0);
                    const float4 bv = *(const float4*)(a_s + s0 + 8);
                    const int rb = 8 * hh;
                    const float p0 = (dir ? (s0 + 0 >= tl) : (s0 + 0 <= tl)) ? sT[sb][rb + 0] * __expf(av.x - mm_t) : 0.f;
                    const float p1 = (dir ? (s0 + 1 >= tl) : (s0 + 1 <= tl)) ? sT[sb][rb + 1] * __expf(av.y - mm_t) : 0.f;
                    const float p2 = (dir ? (s0 + 2 >= tl) : (s0 + 2 <= tl)) ? sT[sb][rb + 2] * __expf(av.z - mm_t) : 0.f;
                    const float p3 = (dir ? (s0 + 3 >= tl) : (s0 + 3 <= tl)) ? sT[sb][rb + 3] * __expf(av.w - mm_t) : 0.f;
                    const float p4 = (dir ? (s0 + 8 >= tl) : (s0 + 8 <= tl)) ? sT[sb][rb + 4] * __expf(bv.x - mm_t) : 0.f;
                    const float p5 = (dir ? (s0 + 9 >= tl) : (s0 + 9 <= tl)) ? sT[sb][rb + 5] * __expf(bv.y - mm_t) : 0.f;
                    const float p6 = (dir ? (s0 + 10 >= tl) : (s0 + 10 <= tl)) ? sT[sb][rb + 6] * __expf(bv.z - mm_t) : 0.f;
                    const float p7 = (dir ? (s0 + 11 >= tl) : (s0 + 11 <= tl)) ? sT[sb][rb + 7] * __expf(bv.w - mm_t) : 0.f;
                    cs += ((p0 + p1) + (p2 + p3)) + ((p4 + p5) + (p6 + p7));
                    pu = make_uint4(cvtpk(p0, p1), cvtpk(p2, p3), cvtpk(p4, p5), cvtpk(p6, p7));
                }
                const int ksl = sb * 2 + hh;
                const uint2 v0 = *(const uint2*)(VTs + lds_off8(eb * 32 + lr, ksl * 16 + 4 * g));
                const uint2 v1 = *(const uint2*)(VTs + lds_off8(eb * 32 + lr, ksl * 16 + 8 + 4 * g));
                num = MFMA(u4_to_frag(make_uint4(v0.x, v0.y, v1.x, v1.y)), u4_to_frag(pu), num);
            }
        }
        cs += __shfl_xor(cs, 32);
        {
            const float den = w_t * qn + cs;
            const float inv = 1.f / fmaxf(fabsf(den), einv_t);
            unsigned short* hp = WS{p.ws}.hdir() + (size_t)dir * NTOK * 256 + (size_t)(r0 + tl) * 256 + head * 64 + eb * 32 + 4 * g;
#pragma unroll
            for (int j = 0; j < 4; ++j) {
                uint2 o;
                o.x = cvtpk(num[4 * j] * inv, num[4 * j + 1] * inv);
                o.y = cvtpk(num[4 * j + 2] * inv, num[4 * j + 3] * inv);
                *(uint2*)(hp + 8 * j) = o;
            }
        }
#pragma unroll
        for (int r = 0; r < 16; ++r) CT[r] *= decay;
        float nsum = 0.f;
#pragma unroll
        for (int ks = 0; ks < 4; ++ks) {
            const bf16x8 kf = lds_frag(KTs, tb * 32 + lr, ks * 2 + g);
            const float4 w0 = *(const float4*)(wg_s + ks * 16 + g * 8);
            const float4 w1 = *(const float4*)(wg_s + ks * 16 + g * 8 + 4);
            float e0 = bf2f(kf[0]) * w0.x, e1 = bf2f(kf[1]) * w0.y, e2 = bf2f(kf[2]) * w0.z, e3 = bf2f(kf[3]) * w0.w;
            float e4 = bf2f(kf[4]) * w1.x, e5 = bf2f(kf[5]) * w1.y, e6 = bf2f(kf[6]) * w1.z, e7 = bf2f(kf[7]) * w1.w;
            nsum += (e0 + e1) + (e2 + e3) + (e4 + e5) + (e6 + e7);
            const uint4 ku = make_uint4(cvtpk(e0, e1), cvtpk(e2, e3), cvtpk(e4, e5), cvtpk(e6, e7));
            const bf16x8 vf = lds_frag(VTs, eb * 32 + lr, ks * 2 + g);
            CT = MFMA(u4_to_frag(ku), vf, CT);
        }
        nsum += __shfl_xor(nsum, 32);
        if (eb == 0 && g == 0) n_s[nxt * 64 + tb * 32 + lr] = decay * n_s[cur * 64 + tb * 32 + lr] + nsum;
#pragma unroll
        for (int j = 0; j < 4; ++j) {
            uint2 o;
            o.x = cvtpk(CT[4 * j], CT[4 * j + 1]);
            o.y = cvtpk(CT[4 * j + 2], CT[4 * j + 3]);
            *(uint2*)(Cs + nxt * 8192 + lds_off8(eb * 32 + lr, tb * 32 + 8 * j + 4 * g)) = o;
        }
        m = m_new;
    }
}

DI void attn_item(const int wv, const Params& p, const int l_, const int item, const bool isctx, char* smem) {
    const int l = opaque_s(l_);
    const int tid = opaque_tid(wv), lane = tid & 63, w = tid >> 6, g = lane >> 5, lr = lane & 31;
    const int lrow = tid >> 3, lch = tid & 7;
    int b, kvh, q0, qrow0;
    if (!isctx) { b = item >> 8; kvh = (item >> 7) & 1; q0 = (item & 127) * 64; qrow0 = b * SEQ + q0; }
    else { b = item >> 3; kvh = (item >> 2) & 1; q0 = (item & 3) * 64; qrow0 = NLAT + b * CTXL + q0; }
    const int h = kvh * 4 + w;
    char* Ks = smem;
    char* VTs = smem + 8192;
    char* Qw = smem + 16384 + w * 8192;
    __syncthreads();
#pragma unroll
    for (int i = 0; i < 8; ++i) {
        const int row = (lane >> 3) + 8 * i, ch = lane & 7;
        *(uint4*)(Qw + lds_off(row, ch)) = *(const uint4*)(WS{p.ws}.P() + (size_t)(qrow0 + row) * PSTR + C_AQ + h * 64 + ch * 8);
    }
    const float sinkv = p.sink[l * 8 + h];
    float mrun0 = sinkv, mrun1 = sinkv;
    float lrun0 = g == 0 ? 1.f : 0.f, lrun1 = lrun0;
    f32x16 O00, O01, O10, O11;
#pragma unroll
    for (int r = 0; r < 16; ++r) { O00[r] = 0.f; O01[r] = 0.f; O10[r] = 0.f; O11[r] = 0.f; }
    int kstart = 0, ntl = 0;
    if (!isctx) {
        kstart = q0 - 128 < 0 ? 0 : q0 - 128;
        int kend = q0 + 192 > SEQ ? SEQ : q0 + 192;
        ntl = (kend - kstart) >> 6;
    }
    for (int tix = 0; tix < ntl + 4; ++tix) {
        const bool local = tix < ntl;
        const int kpos0 = kstart + tix * 64;
        const int krow0 = local ? b * SEQ + kpos0 : NLAT + b * CTXL + (tix - ntl) * 64;
        const uint4 kr0 = *(const uint4*)(WS{p.ws}.P() + (size_t)(krow0 + lrow) * PSTR + C_AK + kvh * 64 + lch * 8);
        const uint4 kr1 = *(const uint4*)(WS{p.ws}.P() + (size_t)(krow0 + lrow + 32) * PSTR + C_AK + kvh * 64 + lch * 8);
        const uint4 vr0 = *(const uint4*)(WS{p.ws}.AVT() + (size_t)(kvh * 64 + lrow) * NTOK + krow0 + lch * 8);
        const uint4 vr1 = *(const uint4*)(WS{p.ws}.AVT() + (size_t)(kvh * 64 + lrow + 32) * NTOK + krow0 + lch * 8);
        __syncthreads();
        *(uint4*)(Ks + lds_off(lrow, lch)) = kr0;
        *(uint4*)(Ks + lds_off(lrow + 32, lch)) = kr1;
        *(uint4*)(VTs + lds_off(lrow, lch)) = vr0;
        *(uint4*)(VTs + lds_off(lrow + 32, lch)) = vr1;
        __syncthreads();
#pragma unroll
        for (int qb = 0; qb < 2; ++qb) {
#pragma unroll
            for (int kb = 0; kb < 2; ++kb) {
                __builtin_amdgcn_sched_barrier(0);
                f32x16 s0;
#pragma unroll
                for (int r = 0; r < 16; ++r) s0[r] = 0.f;
#pragma unroll
                for (int ks = 0; ks < 4; ++ks)
                    s0 = MFMA(lds_frag(Ks, kb * 32 + lr, ks * 2 + g), lds_frag(Qw, qb * 32 + lr, ks * 2 + g), s0);
                if (local) {
                    const int dq = q0 + qb * 32 + lr - (kpos0 + kb * 32 + 4 * g);
#pragma unroll
                    for (int r = 0; r < 16; ++r) {
                        const int d0 = dq - ((r & 3) + 8 * (r >> 2));
                        s0[r] = ((d0 <= 128) && (d0 >= -128)) ? s0[r] : -1.0e30f;
                    }
                }
                float tmax = s0[0];
#pragma unroll
                for (int r = 1; r < 16; ++r) tmax = fmaxf(tmax, s0[r]);
                tmax = fmaxf(tmax, __shfl_xor(tmax, 32));
                const float mold = qb == 0 ? mrun0 : mrun1;
                const float mnew = fmaxf(mold, tmax);
                const float alpha = __expf(mold - mnew);
                float ls = 0.f;
#pragma unroll
                for (int r = 0; r < 16; ++r) {
                    s0[r] = __expf(s0[r] - mnew);
                    ls += s0[r];
                }
                if (qb == 0) { mrun0 = mnew; lrun0 = lrun0 * alpha + ls; }
                else { mrun1 = mnew; lrun1 = lrun1 * alpha + ls; }
                if (__any(alpha != 1.f)) {
#pragma unroll
                    for (int r = 0; r < 16; ++r) {
                        if (qb == 0) { O00[r] *= alpha; O10[r] *= alpha; }
                        else { O01[r] *= alpha; O11[r] *= alpha; }
                    }
                }
#pragma unroll
                for (int hh = 0; hh < 2; ++hh) {
                    const uint4 pu = make_uint4(cvtpk(s0[8 * hh + 0], s0[8 * hh + 1]), cvtpk(s0[8 * hh + 2], s0[8 * hh + 3]), cvtpk(s0[8 * hh + 4], s0[8 * hh + 5]), cvtpk(s0[8 * hh + 6], s0[8 * hh + 7]));
                    const bf16x8 pf = u4_to_frag(pu);
                    const int ksl = kb * 2 + hh;
                    {
                        const uint2 v0 = *(const uint2*)(VTs + lds_off8(lr, ksl * 16 + 4 * g));
                        const uint2 v1 = *(const uint2*)(VTs + lds_off8(lr, ksl * 16 + 8 + 4 * g));
                        const bf16x8 vf = u4_to_frag(make_uint4(v0.x, v0.y, v1.x, v1.y));
                        if (qb == 0) O00 = MFMA(vf, pf, O00); else O01 = MFMA(vf, pf, O01);
                    }
                    {
                        const uint2 v0 = *(const uint2*)(VTs + lds_off8(32 + lr, ksl * 16 + 4 * g));
                        const uint2 v1 = *(const uint2*)(VTs + lds_off8(32 + lr, ksl * 16 + 8 + 4 * g));
                        const bf16x8 vf = u4_to_frag(make_uint4(v0.x, v0.y, v1.x, v1.y));
                        if (qb == 0) O10 = MFMA(vf, pf, O10); else O11 = MFMA(vf, pf, O11);
                    }
                }
            }
        }
    }
#pragma unroll
    for (int qb = 0; qb < 2; ++qb) {
        const float lrn = qb == 0 ? lrun0 : lrun1;
        const float lt = lrn + __shfl_xor(lrn, 32);
        const float inv = 1.f / lt;
        unsigned short* op = WS{p.ws}.mix() + (size_t)(qrow0 + qb * 32 + lr) * 1024 + 256 + h * 64 + 4 * g;
#pragma unroll
        for (int j = 0; j < 4; ++j) {
            uint2 o;
            const f32x16& A = qb == 0 ? O00 : O01;
            const f32x16& B = qb == 0 ? O10 : O11;
            o.x = cvtpk(A[4 * j] * inv, A[4 * j + 1] * inv);
            o.y = cvtpk(A[4 * j + 2] * inv, A[4 * j + 3] * inv);
            *(uint2*)(op + 8 * j) = o;
            o.x = cvtpk(B[4 * j] * inv, B[4 * j + 1] * inv);
            o.y = cvtpk(B[4 * j + 2] * inv, B[4 * j + 3] * inv);
            *(uint2*)(op + 32 + 8 * j) = o;
        }
    }
}

DI void conv_item(const int wv, const Params& p, const int l_, const int item, const bool isctx, char* smem) {
    const int l = opaque_s(l_);
    const int tid = opaque_tid(wv), lane = tid & 63, w = tid >> 6;
    int rowbase, L, t0;
    if (!isctx) { const int b = item >> 8; rowbase = b * SEQ; L = SEQ; t0 = (item & 255) * 32; }
    else { const int b = item >> 3; rowbase = NLAT + b * CTXL; L = CTXL; t0 = (item & 7) * 32; }
    float* ys = (float*)smem;
    __syncthreads();
    for (int u = tid; u < 62 * 32; u += 256) {
        const int rr = u >> 5, c8 = (u & 31) * 8;
        const int t = t0 - 15 + rr;
        float y[8];
        if (t >= 0 && t < L) {
            const uint4 av = *(const uint4*)(WS{p.ws}.P() + (size_t)(rowbase + t) * PSTR + C_CV + c8);
            const uint4 gv = *(const uint4*)(WS{p.ws}.P() + (size_t)(rowbase + t) * PSTR + C_CV + 256 + c8);
            y[0] = bflo(av.x) * sigmoid_f(bflo(gv.x)); y[1] = bfhi(av.x) * sigmoid_f(bfhi(gv.x));
            y[2] = bflo(av.y) * sigmoid_f(bflo(gv.y)); y[3] = bfhi(av.y) * sigmoid_f(bfhi(gv.y));
            y[4] = bflo(av.z) * sigmoid_f(bflo(gv.z)); y[5] = bfhi(av.z) * sigmoid_f(bfhi(gv.z));
            y[6] = bflo(av.w) * sigmoid_f(bflo(gv.w)); y[7] = bfhi(av.w) * sigmoid_f(bfhi(gv.w));
        } else {
#pragma unroll
            for (int i = 0; i < 8; ++i) y[i] = 0.f;
        }
        *(float4*)(ys + rr * 256 + c8) = make_float4(y[0], y[1], y[2], y[3]);
        *(float4*)(ys + rr * 256 + c8 + 4) = make_float4(y[4], y[5], y[6], y[7]);
    }
    float wj[31];
#pragma unroll
    for (int j = 0; j < 31; ++j) wj[j] = p.dw_w[(size_t)l * 31 * 256 + j * 256 + tid];
    const float bias = p.dw_b[l * 256 + tid];
    __syncthreads();
    float z[32];
#pragma unroll
    for (int t = 0; t < 32; ++t) z[t] = bias;
#pragma unroll
    for (int rr = 0; rr < 62; ++rr) {
        const float yv = ys[rr * 256 + tid];
#pragma unroll
        for (int t = 0; t < 32; ++t) {
            const int j = rr - t;
            if (j >= 0 && j < 31) z[t] += yv * wj[j];
        }
    }
    __syncthreads();
#pragma unroll
    for (int t = 0; t < 32; ++t) ys[t * 256 + tid] = z[t];
    __syncthreads();
    const float4 lg = *(const float4*)(p.ln_g + l * 256 + lane * 4);
    const float4 lb = *(const float4*)(p.ln_b + l * 256 + lane * 4);
#pragma unroll
    for (int q = 0; q < 8; ++q) {
        const int t = w * 8 + q;
        const float4 zv = *(const float4*)(ys + t * 256 + lane * 4);
        float s = zv.x + zv.y + zv.z + zv.w;
#pragma unroll
        for (int o = 32; o >= 1; o >>= 1) s += __shfl_xor(s, o);
        const float mu = s * (1.f / 256.f);
        const float d0 = zv.x - mu, d1 = zv.y - mu, d2 = zv.z - mu, d3 = zv.w - mu;
        float v = d0 * d0 + d1 * d1 + d2 * d2 + d3 * d3;
#pragma unroll
        for (int o = 32; o >= 1; o >>= 1) v += __shfl_xor(v, o);
        const float rstd = rsqrtf(v * (1.f / 256.f) + EPS);
        const float o0 = silu_f(d0 * rstd * lg.x + lb.x), o1 = silu_f(d1 * rstd * lg.y + lb.y);
        const float o2 = silu_f(d2 * rstd * lg.z + lb.z), o3 = silu_f(d3 * rstd * lg.w + lb.w);
        uint2 o;
        o.x = cvtpk(o0, o1);
        o.y = cvtpk(o2, o3);
        *(uint2*)(WS{p.ws}.mix() + (size_t)(rowbase + t0 + t) * 1024 + 768 + lane * 4) = o;
    }
}

DI void phase_mixers(const int wv, const Params& p, const int l, char* smem) {
    const int n_chain = 64;
    const int n_al = NB * 2 * 128;
    const int n_ac = (l == 0) ? NB * 2 * 4 : 0;
    const int n_cl = NB * 256;
    const int n_cc = (l == 0) ? NB * 8 : 0;
    const int total = n_chain + n_al + n_ac + n_cl + n_cc;
    int* slot = (int*)(smem + 65536 - 16);
    for (;;) {
        __syncthreads();
        if (opaque_tid(wv) == 0) *slot = (int)atomicAdd(WS{p.ws}.ctr() + l, 1u);
        __syncthreads();
        int it = *slot;
        if (it >= total) break;
        if (it < n_chain) { mlstm_chain(wv, p, l, it, smem); continue; }
        it -= n_chain;
        if (it < n_al) { attn_item(wv, p, l, it, false, smem); continue; }
        it -= n_al;
        if (it < n_ac) { attn_item(wv, p, l, it, true, smem); continue; }
        it -= n_ac;
        if (it < n_cl) { conv_item(wv, p, l, it, false, smem); continue; }
        it -= n_cl;
        conv_item(wv, p, l, it, true, smem);
    }
}

DI void phase_mfinal(const int wv, const Params& p, const int l) {
    const int tid = opaque_tid(wv);
    const int nrows = (l == 0) ? NTOK : NLAT;
    const int rsub = tid >> 5, c8 = (tid & 31) * 8;
    const float4 g0 = *(const float4*)(p.head_gain + l * 256 + c8);
    const float4 g1 = *(const float4*)(p.head_gain + l * 256 + c8 + 4);
    const float gg[8] = {g0.x, g0.y, g0.z, g0.w, g1.x, g1.y, g1.z, g1.w};
    for (int rb = blockIdx.x; rb < nrows / 8; rb += gridDim.x) {
        const int r = rb * 8 + rsub;
        const uint4 a = *(const uint4*)(WS{p.ws}.hdir() + (size_t)r * 256 + c8);
        const uint4 b = *(const uint4*)(WS{p.ws}.hdir() + (size_t)NTOK * 256 + (size_t)r * 256 + c8);
        const uint4 ov = *(const uint4*)(WS{p.ws}.P() + (size_t)r * PSTR + C_MO + c8);
        float hv[8], o8[8];
        hv[0] = bflo(a.x) + bflo(b.x); hv[1] = bfhi(a.x) + bfhi(b.x);
        hv[2] = bflo(a.y) + bflo(b.y); hv[3] = bfhi(a.y) + bfhi(b.y);
        hv[4] = bflo(a.z) + bflo(b.z); hv[5] = bfhi(a.z) + bfhi(b.z);
        hv[6] = bflo(a.w) + bflo(b.w); hv[7] = bfhi(a.w) + bfhi(b.w);
        o8[0] = bflo(ov.x); o8[1] = bfhi(ov.x); o8[2] = bflo(ov.y); o8[3] = bfhi(ov.y);
        o8[4] = bflo(ov.z); o8[5] = bfhi(ov.z); o8[6] = bflo(ov.w); o8[7] = bfhi(ov.w);
        float s = 0.f;
#pragma unroll
        for (int i = 0; i < 8; ++i) s += hv[i] * hv[i];
        s += __shfl_xor(s, 1);
        s += __shfl_xor(s, 2);
        s += __shfl_xor(s, 4);
        const float rstd = rsqrtf(s * (1.f / 64.f) + EPS);
        float y[8];
#pragma unroll
        for (int i = 0; i < 8; ++i) y[i] = hv[i] * rstd * gg[i] * sigmoid_f(o8[i]);
        *(uint4*)(WS{p.ws}.mix() + (size_t)r * 1024 + c8) = make_uint4(cvtpk(y[0], y[1]), cvtpk(y[2], y[3]), cvtpk(y[4], y[5]), cvtpk(y[6], y[7]));
    }
}

DI void phase_final(const int wv, const Params& p) {
    const int tid = opaque_tid(wv), lane = tid & 63, w = tid >> 6;
    for (int rb = blockIdx.x; rb < NLAT / 4; rb += gridDim.x) {
        const int r = rb * 4 + w;
        float* xp = p.out + (size_t)r * 1024;
        float4 v[4];
        float s = 0.f;
#pragma unroll
        for (int i = 0; i < 4; ++i) {
            v[i] = *(const float4*)(xp + i * 256 + lane * 4);
            s += v[i].x * v[i].x + v[i].y * v[i].y + v[i].z * v[i].z + v[i].w * v[i].w;
        }
#pragma unroll
        for (int o = 32; o >= 1; o >>= 1) s += __shfl_xor(s, o);
        const float rstd = rsqrtf(s * (1.f / 1024.f) + EPS);
#pragma unroll
        for (int i = 0; i < 4; ++i) {
            const float4 gn = *(const float4*)(p.final_gain + i * 256 + lane * 4);
            *(float4*)(xp + i * 256 + lane * 4) = make_float4(v[i].x * rstd * gn.x, v[i].y * rstd * gn.y, v[i].z * rstd * gn.z, v[i].w * rstd * gn.w);
        }
    }
}

__global__ void __launch_bounds__(256, 2) fwd_megakernel(Params p) {
    __shared__ __attribute__((aligned(16))) char smem[65536];
    cg::grid_group grid = cg::this_grid();
    const int wv = __builtin_amdgcn_readfirstlane((int)(threadIdx.x >> 6));
    phase0a(wv, p, smem);
    grid.sync();
    phase0c(wv, p, smem);
    grid.sync();
#pragma unroll 1
    for (int l = 0; l < 2; ++l) {
        phase_inproj(wv, p, l, smem);
        grid.sync();
        phase_mixers(wv, p, l, smem);
        grid.sync();
        phase_mfinal(wv, p, l);
        grid.sync();
        phase_resid<0>(wv, p, l, smem);
        grid.sync();
        phase_ffnin(wv, p, l, smem);
        grid.sync();
        phase_resid<1>(wv, p, l, smem);
        grid.sync();
    }
    phase_final(wv, p);
}

extern "C" void kernel_launch(void* const* d_in, const int* in_sizes, int n_in, void* d_out, int out_size, void* d_ws,
                              size_t ws_size, hipStream_t stream) {
    static int grid_blocks = 0;
    if (!grid_blocks) {
        int dev = 0, cus = 0, per_cu = 0;
        hipGetDevice(&dev);
        hipDeviceGetAttribute(&cus, hipDeviceAttributeMultiprocessorCount, dev);
        hipOccupancyMaxActiveBlocksPerMultiprocessor(&per_cu, fwd_megakernel, 256, 0);
        if (per_cu > 2) per_cu = 2;
        if (per_cu < 1) per_cu = 1;
        grid_blocks = cus * per_cu;
    }
    Params p{};
    p.x = (const float*)d_in[0]; p.c = (const float*)d_in[1]; p.ctx = (const float*)d_in[2]; p.c_ctx = (const float*)d_in[3];
    p.w_mod = (const float*)d_in[4]; p.b_mod = (const float*)d_in[5]; p.norm_gain = (const float*)d_in[6]; p.w_in = (const float*)d_in[7];
    p.gate_bias = (const float*)d_in[8]; p.head_gain = (const float*)d_in[9]; p.sink = (const float*)d_in[10];
    p.dw_w = (const float*)d_in[11]; p.dw_b = (const float*)d_in[12]; p.ln_g = (const float*)d_in[13]; p.ln_b = (const float*)d_in[14];
    p.pw_w = (const float*)d_in[15]; p.w_out = (const float*)d_in[16]; p.w_ffn_in = (const float*)d_in[17]; p.w_ffn_out = (const float*)d_in[18];
    p.final_gain = (const float*)d_in[19];
    p.out = (float*)d_out;
    p.ws = (char*)d_ws;
    if (O_END > ws_size) fprintf(stderr, "workspace too small: need %zu have %zu\n", (size_t)O_END, ws_size);
    void* args[] = {&p};
    hipError_t e = hipLaunchCooperativeKernel((void*)fwd_megakernel, dim3(grid_blocks), dim3(256), args, 0, stream);
    if (e != hipSuccess) fprintf(stderr, "cooperative launch failed: %s (grid %d)\n", hipGetErrorString(e), grid_blocks);
}
```

```cpp
#include <hip/hip_runtime.h>
#include <hip/hip_cooperative_groups.h>
#include <cstdio>
#include <cstdint>
namespace cg = cooperative_groups;

#define DI __device__ __forceinline__
typedef __attribute__((ext_vector_type(8))) short bf16x8;
typedef __attribute__((ext_vector_type(16))) float f32x16;
#define MFMA(a, b, c) __builtin_amdgcn_mfma_f32_32x32x16_bf16((a), (b), (c), 0, 0, 0)

constexpr int DM = 1024;
constexpr int NB = 8;
constexpr int SEQ = 8192;
constexpr int CTXL = 256;
constexpr int NLAT = NB * SEQ;
constexpr int NCTX = NB * CTXL;
constexpr int NTOK = NLAT + NCTX;
constexpr int INC = 2320;
constexpr int NP = 2560;
constexpr int PSTR = 2304;
constexpr int FFN = 2816;
constexpr int FFN2 = 5632;
constexpr int C_MQ = 0, C_MK = 256, C_MV = 512, C_MO = 768, C_AQ = 1024, C_AK = 1536, C_AV = 1664, C_CV = 1792;
constexpr float EPS = 1e-6f;

constexpr size_t al256(size_t v) { return (v + 255) & ~(size_t)255; }
constexpr size_t O_WTIN = 0;
constexpr size_t O_WTOUT = O_WTIN + al256((size_t)2 * NP * 1024 * 2);
constexpr size_t O_WTF1 = O_WTOUT + al256((size_t)2 * 1024 * 1024 * 2);
constexpr size_t O_WTF2 = O_WTF1 + al256((size_t)2 * FFN2 * 1024 * 2);
constexpr size_t O_MODV = O_WTF2 + al256((size_t)2 * 1024 * FFN * 2);
constexpr size_t O_SHW1 = O_MODV + al256((size_t)2 * 6 * 9 * 1024 * 4);
constexpr size_t O_SHW2 = O_SHW1 + al256((size_t)2 * 9 * NP * 4);
constexpr size_t O_ROPE = O_SHW2 + al256((size_t)2 * 9 * FFN2 * 4);
constexpr size_t O_CTR = O_ROPE + al256((size_t)128 * 16 * 2 * 4);
constexpr size_t O_BAR = O_CTR + 256;
constexpr size_t O_ROWSQ = O_BAR + 16384;
constexpr size_t O_XG = O_ROWSQ + al256((size_t)5 * NTOK * 4);
constexpr size_t O_CTXA = O_XG + al256((size_t)NTOK * 1024 * 2);
constexpr size_t O_MIX = O_CTXA + al256((size_t)NCTX * 1024 * 4);
constexpr size_t O_P = O_MIX + al256((size_t)NTOK * 1024 * 2);
constexpr size_t O_MKT = O_P + al256((size_t)NTOK * PSTR * 2);
constexpr size_t O_MVT = O_MKT + al256((size_t)256 * NTOK * 2);
constexpr size_t O_AVT = O_MVT + al256((size_t)256 * NTOK * 2);
constexpr size_t O_GATES = O_AVT + al256((size_t)128 * NTOK * 2);
constexpr size_t O_HDIR = O_GATES + al256((size_t)NTOK * 16 * 4);
constexpr size_t O_END = O_HDIR + al256((size_t)2 * NTOK * 256 * 2);
constexpr size_t O_HID = O_P;
static_assert(O_HID + (size_t)NTOK * FFN * 2 <= O_END, "hid alias overflow");

struct Params {
    const float *x, *c, *ctx, *c_ctx, *w_mod, *b_mod, *norm_gain, *w_in, *gate_bias, *head_gain, *sink,
        *dw_w, *dw_b, *ln_g, *ln_b, *pw_w, *w_out, *w_ffn_in, *w_ffn_out, *final_gain;
    float* out;
    char* ws;
};
typedef const Params __attribute__((address_space(4)))* KP;
DI KP opaque_kp(KP q) { asm volatile("" : "+s"(q)); return q; }
struct WS {
    char* b;
    DI unsigned short* WtIn() const { return (unsigned short*)(b + O_WTIN); }
    DI unsigned short* WtOut() const { return (unsigned short*)(b + O_WTOUT); }
    DI unsigned short* WtF1() const { return (unsigned short*)(b + O_WTF1); }
    DI unsigned short* WtF2() const { return (unsigned short*)(b + O_WTF2); }
    DI float* modv() const { return (float*)(b + O_MODV); }
    DI float* shW1() const { return (float*)(b + O_SHW1); }
    DI float* shW2() const { return (float*)(b + O_SHW2); }
    DI float* rope() const { return (float*)(b + O_ROPE); }
    DI unsigned* ctr() const { return (unsigned*)(b + O_CTR); }
    DI unsigned* bar() const { return (unsigned*)(b + O_BAR); }
    DI float* rowsq() const { return (float*)(b + O_ROWSQ); }
    DI unsigned short* xg() const { return (unsigned short*)(b + O_XG); }
    DI float* ctxa() const { return (float*)(b + O_CTXA); }
    DI unsigned short* mix() const { return (unsigned short*)(b + O_MIX); }
    DI unsigned short* P() const { return (unsigned short*)(b + O_P); }
    DI unsigned short* MKT() const { return (unsigned short*)(b + O_MKT); }
    DI unsigned short* MVT() const { return (unsigned short*)(b + O_MVT); }
    DI unsigned short* AVT() const { return (unsigned short*)(b + O_AVT); }
    DI float* gates() const { return (float*)(b + O_GATES); }
    DI unsigned short* hdir() const { return (unsigned short*)(b + O_HDIR); }
    DI unsigned short* hid() const { return (unsigned short*)(b + O_HID); }
};

DI int opaque_tid(int wv) { int t = wv * 64 + (int)__builtin_amdgcn_mbcnt_hi(~0u, __builtin_amdgcn_mbcnt_lo(~0u, 0u)); asm volatile("" : "+v"(t)); return t; }
DI int opaque_s(int v) { asm volatile("" : "+s"(v)); return v; }
DI unsigned cvtpk(float lo, float hi) { unsigned r; asm("v_cvt_pk_bf16_f32 %0, %1, %2" : "=v"(r) : "v"(lo), "v"(hi)); return r; }
DI float bflo(unsigned u) { return __uint_as_float(u << 16); }
DI float bfhi(unsigned u) { return __uint_as_float(u & 0xffff0000u); }
DI float bf2f(short s) { return __uint_as_float(((unsigned)(unsigned short)s) << 16); }
DI int lds_off(int row, int chunk) { return row * 128 + ((chunk ^ ((row >> 1) & 7)) << 4); }
DI int lds_off8(int row, int k) { return row * 128 + ((((k >> 3)) ^ ((row >> 1) & 7)) << 4) + ((k & 7) << 1); }
DI bf16x8 lds_frag(const char* base, int row, int chunk) { return *(const bf16x8*)(base + lds_off(row, chunk)); }
DI bf16x8 u4_to_frag(uint4 v) { return __builtin_bit_cast(bf16x8, v); }
DI float shfl_i(float v, int srclane) { return __int_as_float(__builtin_amdgcn_ds_bpermute(srclane << 2, __float_as_int(v))); }
#define SX(v, m) shfl_i((v), lane ^ (m))
#define LDS_BARRIER() do { asm volatile("s_waitcnt lgkmcnt(0)" ::: "memory"); __builtin_amdgcn_s_barrier(); asm volatile("" ::: "memory"); } while (0)
DI float silu_f(float v) { return v * __builtin_amdgcn_rcpf(1.f + __expf(-v)); }
DI float sigmoid_f(float v) { return __builtin_amdgcn_rcpf(1.f + __expf(-v)); }


namespace pg8 {
#define PG8_LAS __attribute__((address_space(3)))
typedef unsigned short bf16_t;
typedef short bf16x8 __attribute__((ext_vector_type(8)));
typedef float f32x4 __attribute__((ext_vector_type(4)));
typedef unsigned u32x4 __attribute__((ext_vector_type(4)));
constexpr int BM = 256, BK = 64, HALF = 128, HTB = HALF * BK * 2  , STAGE_BYTES = 8 * HTB, NXCD = 8, WGM = 8;

__host__ __device__ __forceinline__ int lds_byte(int r, int c) { const int st = (r >> 4) * 2 + (c >> 5), rr = r & 15, cc = c & 31, ob = rr * 64 + cc * 2; return st * 1024 + (ob ^ (((ob >> 9) & 1) << 5)); }
__host__ __device__ __forceinline__ void stage_rc(int b, int& R, int& C) { const int st = b / 1024, sb = b % 1024, swz = sb ^ (((sb >> 9) & 1) << 5); R = (st >> 1) * 16 + swz / 64; C = (st & 1) * 32 + (swz % 64) / 2; }
__host__ __device__ __forceinline__ int perm32(int rho) { const int n = rho >> 4, i = rho & 15; return 8 * (i >> 2) + 4 * n + (i & 3); }

struct Unit { int pm, pn; };
struct Gemm { const bf16_t* A; const bf16_t* Bt; int M, N, K; };

struct StaticOrder {
    int nM, nN, nwg, G, c;
    __host__ __device__ void init(int M, int N, int G_, int c_) { nM = M / BM; nN = N / BM; nwg = nM * nN; G = G_; c = c_; }
    __host__ __device__ bool next(int i, Unit& u) const {
        const long L = (long)i * G + c; if (L >= nwg) return false;
        int wgid = (int)L; { const int q = nwg / NXCD, r = nwg % NXCD, xcd = wgid % NXCD, off = wgid / NXCD; wgid = (xcd < r ? xcd * (q + 1) : r * (q + 1) + (xcd - r) * q) + off; }
        const int nig = WGM * nN, gid = wgid / nig, fm = gid * WGM, gsz = (nM - fm) < WGM ? (nM - fm) : WGM;
        u.pm = fm + ((wgid % nig) % gsz); u.pn = (wgid % nig) / gsz; return true;
    }
    __device__ __forceinline__ void a_ready(const Unit&) const {}
    __device__ __forceinline__ void done(const Unit&) const {}
};
template <class Epi, class Sched, bool STAMP = false>
__device__ __forceinline__ void gemm_phase(PG8_LAS unsigned char* lds, const Gemm g, const Sched& S, const Epi& E, unsigned long long* stamps) {
    int tid_o = threadIdx.x; asm volatile("" : "+v"(tid_o));
    const int tid = tid_o, wid = __builtin_amdgcn_readfirstlane(tid >> 6), lane = tid & 63, wr = wid >> 2, wc = wid & 3, fr = lane & 15, fq = lane >> 4;
    const int K = g.K, nt = K / BK;
    int ts_lo = 0, ts_hi = 0, nts = 0; const unsigned long long rt_entry = STAMP ? (unsigned long long)wall_clock64() : 0ull;
#define PG8_STAMP() do { if (STAMP && wid == 0 && nts < 64) { const unsigned long long _c = (unsigned long long)clock64(); \
        ts_lo = (lane == nts) ? (int)(unsigned)_c : ts_lo; ts_hi = (lane == nts) ? (int)(unsigned)(_c >> 32) : ts_hi; ++nts; } } while (0)
    PG8_STAMP();
    unsigned voffA[2], voffB[2];
#pragma unroll
    for (int i = 0; i < 2; ++i) { int R, C; stage_rc(tid * 16 + i * 8192, R, C); const int Rb = Epi::PERM ? ((R & ~31) + perm32(R & 31)) : R;
        voffA[i] = (unsigned)(R * K + C) * 2u; voffB[i] = (unsigned)(Rb * K + C) * 2u; }
    const size_t kstep = (size_t)(BK * 2);
    const size_t hstep = (size_t)HALF * K * 2;
    const size_t tstep = 2 * hstep;
    const unsigned ldsw = (unsigned)wid * 1024u;
    const int aoff = lds_byte(wr * 64 + fr, fq * 8), boff = lds_byte(wc * 32 + fr, fq * 8);
#define PG8_SA(b, h) (((b) * 2 + (h)) * HTB)
#define PG8_SB(b, h) ((4 + (b) * 2 + (h)) * HTB)
#define PG8_STAGE(bufoff, gbase, voff) do { _Pragma("unroll") for (int _i = 0; _i < 2; ++_i) \
        __builtin_amdgcn_global_load_lds((const unsigned*)((const char*)(gbase) + (voff)[_i]), (PG8_LAS unsigned*)(lds + (bufoff) + ldsw + _i * 8192), 16, 0, 0); } while (0)
#define PG8_LDA(dst, b, h) do { _Pragma("unroll") for (int m = 0; m < 4; ++m) _Pragma("unroll") for (int k = 0; k < 2; ++k) dst[m][k] = *(const PG8_LAS bf16x8*)(lds + PG8_SA(b, h) + aoff + m * 2048 + k * 1024); } while (0)
#define PG8_LDB(dst, b, h) do { _Pragma("unroll") for (int n = 0; n < 2; ++n) _Pragma("unroll") for (int k = 0; k < 2; ++k) dst[n][k] = *(const PG8_LAS bf16x8*)(lds + PG8_SB(b, h) + boff + n * 2048 + k * 1024); } while (0)
#define PG8_MMA(ai, bj, At, Bt) do { __builtin_amdgcn_s_setprio(1); _Pragma("unroll") for (int m = 0; m < 4; ++m) _Pragma("unroll") for (int n = 0; n < 2; ++n) _Pragma("unroll") for (int k = 0; k < 2; ++k) \
        acc[ai][bj][m][n] = __builtin_amdgcn_mfma_f32_16x16x32_bf16(Bt[n][k], At[m][k], acc[ai][bj][m][n], 0, 0, 0); __builtin_amdgcn_s_setprio(0); } while (0)
#define PG8_WAIT_V(n) asm volatile("s_waitcnt vmcnt(" #n ")" ::: "memory")
#define PG8_WAIT_L(n) asm volatile("s_waitcnt lgkmcnt(" #n ")" ::: "memory")
#define PG8_BAR __builtin_amdgcn_s_barrier()
#define PG8_SCHED __builtin_amdgcn_sched_barrier(0)
    Unit cur, nxt; int ui = 0;
    if (!S.next(0, cur)) return;
    f32x4 acc[2][2][4][2];
#pragma unroll
    for (int a = 0; a < 2; ++a)
#pragma unroll
        for (int b = 0; b < 2; ++b)
#pragma unroll
            for (int m = 0; m < 4; ++m)
#pragma unroll
                for (int n = 0; n < 2; ++n) acc[a][b][m][n] = (f32x4){0.f, 0.f, 0.f, 0.f};
    bf16x8 At[4][2], B0[2][2], B1[2][2];
    const char* cA = (const char*)g.A + (size_t)cur.pm * tstep; const char* cB = (const char*)g.Bt + (size_t)cur.pn * tstep;
    S.a_ready(cur);
    PG8_STAGE(PG8_SB(0, 0), cB, voffB); PG8_STAGE(PG8_SA(0, 0), cA, voffA); PG8_STAGE(PG8_SB(0, 1), cB + hstep, voffB); PG8_STAGE(PG8_SA(0, 1), cA + hstep, voffA);
    if (wr == 1) PG8_BAR;
    PG8_WAIT_V(4); PG8_BAR;
    PG8_STAGE(PG8_SB(1, 0), cB + kstep, voffB); PG8_STAGE(PG8_SA(1, 0), cA + kstep, voffA); PG8_STAGE(PG8_SB(1, 1), cB + hstep + kstep, voffB);
    PG8_WAIT_V(6); PG8_BAR;
    PG8_STAMP();
    for (;;) {
        const bool has_next = S.next(ui + 1, nxt);
        const char* nA = has_next ? (const char*)g.A + (size_t)nxt.pm * tstep : cA; const char* nB = has_next ? (const char*)g.Bt + (size_t)nxt.pn * tstep : cB;
        for (int t = 0; t < nt; t += 2) {
            const bool last = (t == nt - 2);
            const char* a1 = cA + (size_t)(t + 1) * kstep;
            const char* a2 = last ? nA : cA + (size_t)(t + 2) * kstep; const char* b2 = last ? nB : cB + (size_t)(t + 2) * kstep;
            const char* a3 = a2 + kstep; const char* b3 = b2 + kstep;
            if (last && has_next) S.a_ready(nxt);
            PG8_LDB(B0, 0, 0); PG8_SCHED; PG8_LDA(At, 0, 0); PG8_STAGE(PG8_SA(1, 1), a1 + hstep, voffA);
            PG8_WAIT_L(8); PG8_BAR; PG8_WAIT_L(0); PG8_MMA(0, 0, At, B0); PG8_BAR; PG8_SCHED;
            PG8_LDB(B1, 0, 1); PG8_STAGE(PG8_SB(0, 0), b2, voffB);
            PG8_BAR; PG8_WAIT_L(0); PG8_MMA(0, 1, At, B1); PG8_BAR;
            PG8_LDA(At, 0, 1); PG8_STAGE(PG8_SA(0, 0), a2, voffA);
            PG8_BAR; PG8_WAIT_L(0); PG8_MMA(1, 0, At, B0); PG8_BAR; PG8_SCHED;
            PG8_STAGE(PG8_SB(0, 1), b2 + hstep, voffB);
            PG8_WAIT_V(6); PG8_BAR; PG8_MMA(1, 1, At, B1); PG8_BAR;
            PG8_LDB(B0, 1, 0); PG8_SCHED; PG8_LDA(At, 1, 0); PG8_STAGE(PG8_SA(0, 1), a2 + hstep, voffA);
            PG8_WAIT_L(8); PG8_BAR; PG8_WAIT_L(0); PG8_MMA(0, 0, At, B0); PG8_BAR; PG8_SCHED;
            PG8_LDB(B1, 1, 1); PG8_STAGE(PG8_SB(1, 0), b3, voffB);
            PG8_BAR; PG8_WAIT_L(0); PG8_MMA(0, 1, At, B1); PG8_BAR;
            PG8_LDA(At, 1, 1); PG8_STAGE(PG8_SA(1, 0), a3, voffA);
            PG8_BAR; PG8_WAIT_L(0); PG8_MMA(1, 0, At, B0); PG8_BAR; PG8_SCHED;
            PG8_STAGE(PG8_SB(1, 1), b3 + hstep, voffB);
            PG8_WAIT_V(6); PG8_BAR; PG8_MMA(1, 1, At, B1); PG8_BAR;
        }
        PG8_STAMP();
        if constexpr (!Epi::AFTER_DRAIN) { E(acc, cur, wr, wc, fr, fq); S.done(cur); }
        PG8_STAMP();
        if (!has_next) break;
#pragma unroll
        for (int a = 0; a < 2; ++a)
#pragma unroll
            for (int b = 0; b < 2; ++b)
#pragma unroll
                for (int m = 0; m < 4; ++m)
#pragma unroll
                    for (int n = 0; n < 2; ++n) acc[a][b][m][n] = (f32x4){0.f, 0.f, 0.f, 0.f};
        cur = nxt; cA = nA; cB = nB; ++ui;
    }
    PG8_WAIT_V(0);
    if (wr == 0) PG8_BAR;
    PG8_BAR;
    if constexpr (Epi::AFTER_DRAIN) { E.fused(acc, cur, wr, wc, fr, fq, lds, wid, lane); S.done(cur); }
    PG8_STAMP();
    if (STAMP && wid == 0) { stamps[lane] = lane < nts ? (((unsigned long long)(unsigned)ts_hi << 32) | (unsigned)ts_lo) : 0ull;
        if (lane == 62) stamps[62] = rt_entry; if (lane == 63) stamps[63] = (unsigned long long)wall_clock64(); }
#undef PG8_STAMP
#undef PG8_SA
#undef PG8_SB
#undef PG8_STAGE
#undef PG8_LDA
#undef PG8_LDB
#undef PG8_MMA
#undef PG8_WAIT_V
#undef PG8_WAIT_L
#undef PG8_BAR
#undef PG8_SCHED
}
}
using pg8::f32x4;
using pg8::Unit;
#define LAS __attribute__((address_space(3)))

#define XB_TMO      128
#define XB_XCNT(j)  (256  + 64 * (j))
#define XB_XSUB(j)  (1280 + 64 * (j))
#define XB_XGEN(j)  (2304 + 64 * (j))
#define XB_TOP      3328
#define XB_TOPGEN   3392
#define XCD_BAR_WORDS 3456
#define XB_SPIN_CAP (1u << 18)

__device__ __forceinline__ unsigned xb_ld(unsigned* p)              { return __hip_atomic_load(p, __ATOMIC_RELAXED, __HIP_MEMORY_SCOPE_AGENT); }
__device__ __forceinline__ unsigned xb_add(unsigned* p, unsigned v) { return __hip_atomic_fetch_add(p, v, __ATOMIC_RELAXED, __HIP_MEMORY_SCOPE_AGENT); }
__device__ __forceinline__ unsigned xb_xcc_id() { return (unsigned)__builtin_amdgcn_s_getreg((3 << 11) | 20) & 0xFu; }
#define XB_SPIN(cond, bar) do { unsigned _sp = 0; while (cond) { __builtin_amdgcn_s_sleep(1); \
    if ((++_sp & 255u) == 0u) { if (xb_ld(&(bar)[XB_TMO])) break; if (_sp > XB_SPIN_CAP) { atomicAdd(&(bar)[XB_TMO], 1u); break; } } } } while (0)

struct XcdBarrier {
    unsigned* bar; unsigned x;
    volatile LAS unsigned* st;
};

__device__ __forceinline__ XcdBarrier xcd_barrier_post(unsigned* bar, volatile LAS unsigned* st) {
    XcdBarrier b; b.bar = bar; b.x = xb_xcc_id(); b.st = st;
    if (threadIdx.x == 0) (void)xb_add(&bar[XB_XCNT(b.x)], 1u);
    return b;
}
__device__ __forceinline__ void xcd_barrier_complete(unsigned* bar, unsigned x, unsigned& nloc, unsigned& nx) {
    const unsigned G = gridDim.x * gridDim.y * gridDim.z;
    unsigned sum, cnt, mine, sp = 0u;
    for (;;) {
        sum = 0u; cnt = 0u; mine = 0u;
#pragma unroll
        for (unsigned j = 0; j < 16; ++j) { const unsigned c = xb_ld(&bar[XB_XCNT(j)]); sum += c; cnt += (c > 0u) ? 1u : 0u; mine = (j == x) ? c : mine; }
        if (sum == G) break;
        __builtin_amdgcn_s_sleep(1);
        if ((++sp & 255u) == 0u) { if (xb_ld(&bar[XB_TMO])) break; if (sp > XB_SPIN_CAP) { atomicAdd(&bar[XB_TMO], 1u); break; } }
    }
    nloc = mine > 0u ? mine : 1u; nx = cnt > 0u ? cnt : 1u;
}

__device__ __forceinline__ void xcd_barrier(const XcdBarrier& b, const bool leader_thread) {
    asm volatile("s_waitcnt vmcnt(0)" ::: "memory");
    __syncthreads();
    if (leader_thread) {
        unsigned* bar = b.bar;
        __builtin_amdgcn_s_waitcnt(0);
        unsigned nloc = b.st[0], nx = b.st[1];
        if (nloc == 0u) { xcd_barrier_complete(bar, b.x, nloc, nx); b.st[0] = nloc; b.st[1] = nx; }
        const unsigned old = xb_add(&bar[XB_XSUB(b.x)], 1u);
        const unsigned gen = old / nloc;
        if (old + 1u == (gen + 1u) * nloc) {
            __builtin_amdgcn_fence(__ATOMIC_RELEASE, "agent");
            asm volatile("s_waitcnt vmcnt(0)" ::: "memory");
            const unsigned og = xb_add(&bar[XB_TOP], 1u);
            const unsigned tg = og / nx;
            if (og + 1u == (tg + 1u) * nx) xb_add(&bar[XB_TOPGEN], 1u);
            else XB_SPIN(xb_ld(&bar[XB_TOPGEN]) == tg, bar);
            __builtin_amdgcn_fence(__ATOMIC_ACQUIRE, "agent");
            xb_add(&bar[XB_XGEN(b.x)], 1u);
            asm volatile("s_waitcnt vmcnt(0)" ::: "memory");
        } else {
            XB_SPIN(xb_ld(&bar[XB_XGEN(b.x)]) == gen, bar);
            __builtin_amdgcn_fence(__ATOMIC_ACQUIRE, "agent");
            asm volatile("s_waitcnt vmcnt(0)" ::: "memory");
        }
    }
    __syncthreads();
}


constexpr int LDS_BYTES = 147456;
constexpr int MISC_OFF = 147456 - 256;

DI void p0_mod(const int wv, KP p, int item, char* smem) {
    const int l = item / 96, cb = item % 96;
    const int tid = opaque_tid(wv);
    float* s_l = (float*)smem;
    float* red = s_l + 9 * 1024;
    __syncthreads();
    for (int i = tid; i < 9 * 1024; i += 512) {
        int bb = i >> 10, k = i & 1023;
        float v = bb < 8 ? p->c[bb * 1024 + k] : p->c_ctx[k];
        s_l[i] = v / (1.f + expf(-v));
    }
    __syncthreads();
    const int col = cb * 64 + (tid & 63), kg = tid >> 6;
    float acc[9];
#pragma unroll
    for (int bb = 0; bb < 9; ++bb) acc[bb] = 0.f;
    const float* wp = p->w_mod + (size_t)l * 1024 * 6144 + col;
#pragma unroll 8
    for (int k = kg * 128; k < kg * 128 + 128; ++k) {
        float wv_ = wp[(size_t)k * 6144];
#pragma unroll
        for (int bb = 0; bb < 9; ++bb) acc[bb] += s_l[bb * 1024 + k] * wv_;
    }
#pragma unroll
    for (int bb = 0; bb < 9; ++bb) red[(kg * 9 + bb) * 64 + (tid & 63)] = acc[bb];
    __syncthreads();
    for (int i = tid; i < 9 * 64; i += 512) {
        int bb = i >> 6, cc = i & 63;
        int cg_ = cb * 64 + cc;
        float v = 0.f;
#pragma unroll
        for (int q = 0; q < 8; ++q) v += red[(q * 9 + bb) * 64 + cc];
        v += p->b_mod[l * 6144 + cg_];
        int sec = cg_ >> 10, k = cg_ & 1023;
        if (sec == 1) v = p->norm_gain[(l * 2 + 0) * 1024 + k] * (1.f + v);
        if (sec == 4) v = p->norm_gain[(l * 2 + 1) * 1024 + k] * (1.f + v);
        WS{p->ws}.modv()[((size_t)(l * 6 + sec) * 9 + bb) * 1024 + k] = v;
    }
}

DI void p0_convert(const int wv, KP p, int mode, int l, int kt, int nt, char* smem) {
    float* tile = (float*)smem;
    const int tid = opaque_tid(wv);
    const float* src;
    unsigned short* dst;
    int srcN, K;
    if (mode == 0) { src = p->w_in + (size_t)l * 1024 * INC; srcN = INC; K = 1024; dst = WS{p->ws}.WtIn() + (size_t)l * NP * 1024; }
    else if (mode == 1) { src = p->w_out + (size_t)l * 1024 * 1024; srcN = 1024; K = 1024; dst = WS{p->ws}.WtOut() + (size_t)l * 1024 * 1024; }
    else if (mode == 2) { src = p->w_ffn_in + (size_t)l * 1024 * FFN2; srcN = FFN2; K = 1024; dst = WS{p->ws}.WtF1() + (size_t)l * FFN2 * 1024; }
    else { src = p->w_ffn_out + (size_t)l * FFN * 1024; srcN = 1024; K = FFN; dst = WS{p->ws}.WtF2() + (size_t)l * 1024 * FFN; }
    __syncthreads();
    {
        const int c4 = (tid & 15) * 4;
        const int n = nt * 64 + c4;
        int sc;
        if (mode == 0) {
            int nn = n;
            if (n >= C_AQ && n < C_AV) { const int q = n & 31; nn = (n & ~31) + 16 * ((q >> 2) & 1) + 4 * (q >> 3) + (q & 3); }
            sc = nn < 1024 ? nn : (nn < 2304 ? nn + 16 : (nn < 2320 ? nn - 1280 : -1));
        }
        else if (mode == 2) { int pn_ = n >> 8, wi = n & 255; sc = pn_ * 128 + (wi & 127) + (wi >= 128 ? FFN : 0); }
        else sc = n;
#pragma unroll
        for (int i = 0; i < 2; ++i) {
            const int kk = (tid >> 4) + 32 * i;
            float4 v = make_float4(0.f, 0.f, 0.f, 0.f);
            if (sc >= 0) v = *(const float4*)(src + (size_t)(kt * 64 + kk) * srcN + sc);
            tile[kk * 65 + c4 + 0] = v.x; tile[kk * 65 + c4 + 1] = v.y; tile[kk * 65 + c4 + 2] = v.z; tile[kk * 65 + c4 + 3] = v.w;
        }
    }
    __syncthreads();
    {
        const int n = tid >> 3, k0 = (tid & 7) * 8;
        unsigned o[4];
#pragma unroll
        for (int q = 0; q < 4; ++q) o[q] = cvtpk(tile[(k0 + 2 * q) * 65 + n], tile[(k0 + 2 * q + 1) * 65 + n]);
        unsigned short* d = dst + (size_t)(nt * 64 + n) * K + kt * 64 + k0;
        *(uint4*)d = make_uint4(o[0], o[1], o[2], o[3]);
    }
}

DI void p0_fold(const int wv, KP p, int l, int kt, int nt, char* smem) {
    float* pwS = (float*)smem;
    float* woS = pwS + 64 * 65;
    const int tid = opaque_tid(wv), n = tid & 63, kg = tid >> 6;
    float acc[8];
#pragma unroll
    for (int i = 0; i < 8; ++i) acc[i] = 0.f;
    for (int jc = 0; jc < 4; ++jc) {
        __syncthreads();
        for (int i = tid; i < 64 * 64; i += 512) {
            int r = i >> 6, cc = i & 63;
            pwS[r * 65 + cc] = p->pw_w[(size_t)l * 65536 + (kt * 64 + r) * 256 + jc * 64 + cc];
            woS[r * 64 + cc] = p->w_out[(size_t)l * 1024 * 1024 + (size_t)(768 + jc * 64 + r) * 1024 + nt * 64 + cc];
        }
        __syncthreads();
        for (int j = 0; j < 64; ++j) {
            float wo = woS[j * 64 + n];
#pragma unroll
            for (int i = 0; i < 8; ++i) acc[i] += pwS[(kg * 8 + i) * 65 + j] * wo;
        }
    }
    unsigned o[4];
#pragma unroll
    for (int q = 0; q < 4; ++q) o[q] = cvtpk(acc[2 * q], acc[2 * q + 1]);
    unsigned short* d = WS{p->ws}.WtOut() + (size_t)l * 1024 * 1024 + (size_t)(nt * 64 + n) * 1024 + 768 + kt * 64 + kg * 8;
    *(uint4*)d = make_uint4(o[0], o[1], o[2], o[3]);
}

DI void phase0a(const int wv, KP p, char* smem) {
    const int N_MOD = 192;
    const int N_C0 = 2 * 16 * 40;
    const int N_C1 = 2 * 12 * 16;
    const int N_C2 = 2 * 16 * 88;
    const int N_C3 = 2 * 44 * 16;
    const int N_FOLD = 2 * 4 * 16;
    const int total = N_MOD + N_C0 + N_C1 + N_C2 + N_C3 + N_FOLD + 1;
    for (int it = blockIdx.x; it < total; it += gridDim.x) {
        int i = it;
        if (i < N_MOD) { p0_mod(wv, p, i, smem); continue; }
        i -= N_MOD;
        if (i < N_C0) { int l = i / (16 * 40), r = i % (16 * 40); p0_convert(wv, p, 0, l, r / 40, r % 40, smem); continue; }
        i -= N_C0;
        if (i < N_C1) { int l = i / (12 * 16), r = i % (12 * 16); p0_convert(wv, p, 1, l, r / 16, r % 16, smem); continue; }
        i -= N_C1;
        if (i < N_C2) { int l = i / (16 * 88), r = i % (16 * 88); p0_convert(wv, p, 2, l, r / 88, r % 88, smem); continue; }
        i -= N_C2;
        if (i < N_C3) { int l = i / (44 * 16), r = i % (44 * 16); p0_convert(wv, p, 3, l, r / 16, r % 16, smem); continue; }
        i -= N_C3;
        if (i < N_FOLD) { int l = i / 64, r = i % 64; p0_fold(wv, p, l, r / 16, r % 16, smem); continue; }
        const int tid_m = opaque_tid(wv);
        for (int e = tid_m; e < 128 * 16; e += 512) {
            int pos = e >> 4, f = e & 15;
            float freq = powf(10000.f, -(float)f / 16.f);
            float ang = (float)pos * freq;
            WS{p->ws}.rope()[e * 2 + 0] = cosf(ang);
            WS{p->ws}.rope()[e * 2 + 1] = sinf(ang);
        }
    }
}

DI void phase0c(const int wv, KP p, char* smem) {
    float* shs = (float*)smem;
    const int tid = opaque_tid(wv), lane = tid & 63, w = tid >> 6;
    const int total = 2 * (40 + 88);
    for (int it = blockIdx.x; it < total; it += gridDim.x) {
        const int l = it / 128, r = it % 128;
        const bool second = r >= 40;
        const int nb = second ? r - 40 : r;
        const float* shsrc = WS{p->ws}.modv() + (size_t)((l * 6 + (second ? 3 : 0)) * 9) * 1024;
        const unsigned short* Wt = second ? WS{p->ws}.WtF1() + (size_t)l * FFN2 * 1024 : WS{p->ws}.WtIn() + (size_t)l * NP * 1024;
        float* dst = second ? WS{p->ws}.shW2() + (size_t)l * 9 * FFN2 : WS{p->ws}.shW1() + (size_t)l * 9 * NP;
        const int NN = second ? FFN2 : NP;
        __syncthreads();
        for (int i = tid; i < 9 * 1024; i += 512) shs[i] = shsrc[i];
        __syncthreads();
        for (int q = 0; q < 8; ++q) {
            const int n = nb * 64 + w * 8 + q;
            const unsigned short* wr = Wt + (size_t)n * 1024 + lane * 16;
            uint4 a = *(const uint4*)wr, b = *(const uint4*)(wr + 8);
            float wv_[16];
            wv_[0] = bflo(a.x); wv_[1] = bfhi(a.x); wv_[2] = bflo(a.y); wv_[3] = bfhi(a.y);
            wv_[4] = bflo(a.z); wv_[5] = bfhi(a.z); wv_[6] = bflo(a.w); wv_[7] = bfhi(a.w);
            wv_[8] = bflo(b.x); wv_[9] = bfhi(b.x); wv_[10] = bflo(b.y); wv_[11] = bfhi(b.y);
            wv_[12] = bflo(b.z); wv_[13] = bfhi(b.z); wv_[14] = bflo(b.w); wv_[15] = bfhi(b.w);
#pragma unroll
            for (int bb = 0; bb < 9; ++bb) {
                float s = 0.f;
#pragma unroll
                for (int e = 0; e < 16; ++e) s += wv_[e] * shs[bb * 1024 + lane * 16 + e];
#pragma unroll
                for (int o = 32; o >= 1; o >>= 1) s += SX(s, o);
                if (lane == 0) dst[(size_t)bb * NN + n] = s;
            }
        }
    }
    float* rq = WS{p->ws}.rowsq();
    for (int rb = blockIdx.x; rb < NTOK / 8; rb += gridDim.x) {
        const int r = rb * 8 + w;
        const int bb = r < NLAT ? (r >> 13) : 8;
        const float* xp = r < NLAT ? p->x + (size_t)r * 1024 : p->ctx + (size_t)(r - NLAT) * 1024;
        const float* Gv = WS{p->ws}.modv() + (size_t)((0 * 6 + 1) * 9 + bb) * 1024;
        float s = 0.f;
#pragma unroll
        for (int i = 0; i < 4; ++i) {
            const float4 v = *(const float4*)(xp + i * 256 + lane * 4);
            const float4 gq = *(const float4*)(Gv + i * 256 + lane * 4);
            s += v.x * v.x + v.y * v.y + v.z * v.z + v.w * v.w;
            uint2 o;
            o.x = cvtpk(v.x * gq.x, v.y * gq.y);
            o.y = cvtpk(v.z * gq.z, v.w * gq.w);
            *(uint2*)(WS{p->ws}.xg() + (size_t)r * 1024 + i * 256 + lane * 4) = o;
        }
#pragma unroll
        for (int o = 32; o >= 1; o >>= 1) s += SX(s, o);
        if (lane == 0) rq[r] = s;
    }
}

struct EpiInproj {
    static constexpr bool PERM = true, AFTER_DRAIN = false;
    char* ws; int l;
    DI void operator()(const f32x4 (&acc)[2][2][4][2], const Unit& u, int wr, int wc, int fr, int fq) const {
        asm volatile("" : "+v"(fr), "+v"(fq));
        asm volatile("" : "+s"(wr), "+s"(wc));
        const WS W{ws};
        const int pn = u.pn, r0 = u.pm * 256;
        const int bb = r0 < NLAT ? (r0 >> 13) : 8;
        const float* sh = W.shW1() + (size_t)(l * 9 + bb) * NP;
        const float* rq = W.rowsq() + (size_t)(l * 2) * NTOK + r0 + 64 * wr + fr;
        unsigned short* P = W.P();
        float rs[2][4];
#pragma unroll
        for (int ai = 0; ai < 2; ++ai)
#pragma unroll
            for (int m = 0; m < 4; ++m) rs[ai][m] = rq[128 * ai + 16 * m];
#pragma unroll
        for (int bj = 0; bj < 2; ++bj) {
            const int cb = 256 * pn + 128 * bj + 32 * wc + 8 * fq;
            const float4 s0 = *(const float4*)(sh + cb);
            const float4 s1 = *(const float4*)(sh + cb + 4);
            const bool is_aq = (pn == 4 || pn == 5), is_ak = (pn == 6 && bj == 0), is_av = (pn == 6 && bj == 1);
#pragma unroll
            for (int ai = 0; ai < 2; ++ai)
#pragma unroll
                for (int m = 0; m < 4; ++m) {
                    const int r = r0 + 128 * ai + 64 * wr + 16 * m + fr;
                    const float rstd = rsqrtf(rs[ai][m] * (1.f / 1024.f) + EPS);
                    float v0[4], v1[4];
                    v0[0] = rstd * acc[ai][bj][m][0][0] + s0.x; v0[1] = rstd * acc[ai][bj][m][0][1] + s0.y;
                    v0[2] = rstd * acc[ai][bj][m][0][2] + s0.z; v0[3] = rstd * acc[ai][bj][m][0][3] + s0.w;
                    v1[0] = rstd * acc[ai][bj][m][1][0] + s1.x; v1[1] = rstd * acc[ai][bj][m][1][1] + s1.y;
                    v1[2] = rstd * acc[ai][bj][m][1][2] + s1.z; v1[3] = rstd * acc[ai][bj][m][1][3] + s1.w;
                    if (pn == 9) {
                        if (bj == 0 && wc == 0 && fq < 2) {
                            *(float4*)(W.gates() + (size_t)r * 16 + 8 * fq) = make_float4(v0[0], v0[1], v0[2], v0[3]);
                            *(float4*)(W.gates() + (size_t)r * 16 + 8 * fq + 4) = make_float4(v1[0], v1[1], v1[2], v1[3]);
                        }
                        continue;
                    }
                    if (is_aq || is_ak) {
                        if (r < NLAT) {
                            const int t = r & (SEQ - 1);
                            const int pos = ((wc & 1) == 0) ? (t >> 6) : (t & 63);
                            const float4 cs0 = *(const float4*)(W.rope() + (size_t)(pos * 16 + 4 * fq) * 2);
                            const float4 cs1 = *(const float4*)(W.rope() + (size_t)(pos * 16 + 4 * fq) * 2 + 4);
                            const float cc[4] = {cs0.x, cs0.z, cs1.x, cs1.z};
                            const float sn[4] = {cs0.y, cs0.w, cs1.y, cs1.w};
#pragma unroll
                            for (int i = 0; i < 4; ++i) {
                                const float x1 = v0[i], x2 = v1[i];
                                v0[i] = x1 * cc[i] - x2 * sn[i];
                                v1[i] = x2 * cc[i] + x1 * sn[i];
                            }
                        }
                        if (is_aq) {
#pragma unroll
                            for (int i = 0; i < 4; ++i) { v0[i] *= 0.125f * 1.44269504089f; v1[i] *= 0.125f * 1.44269504089f; }
                        }
                        const int c32 = 256 * pn + 128 * bj + 32 * wc;
                        uint2 o;
                        o.x = cvtpk(v0[0], v0[1]); o.y = cvtpk(v0[2], v0[3]);
                        *(uint2*)(P + (size_t)r * PSTR + c32 + 4 * fq) = o;
                        o.x = cvtpk(v1[0], v1[1]); o.y = cvtpk(v1[2], v1[3]);
                        *(uint2*)(P + (size_t)r * PSTR + c32 + 16 + 4 * fq) = o;
                        continue;
                    }
                    if (pn == 1) {
#pragma unroll
                        for (int i = 0; i < 4; ++i) { v0[i] *= 0.125f; v1[i] *= 0.125f; }
                    }
                    if (!(pn == 2 || is_av))
                        *(uint4*)(P + (size_t)r * PSTR + cb) = make_uint4(cvtpk(v0[0], v0[1]), cvtpk(v0[2], v0[3]), cvtpk(v1[0], v1[1]), cvtpk(v1[2], v1[3]));
                    if (pn == 1 || pn == 2 || is_av) {
                        unsigned short* T = pn == 1 ? W.MKT() : (pn == 2 ? W.MVT() : W.AVT());
                        const int nb2 = cb - (pn == 1 ? C_MK : (pn == 2 ? C_MV : C_AV));
#pragma unroll
                        for (int i = 0; i < 4; ++i) {
                            T[(size_t)(nb2 + i) * NTOK + r] = (unsigned short)(cvtpk(v0[i], 0.f) & 0xffffu);
                            T[(size_t)(nb2 + 4 + i) * NTOK + r] = (unsigned short)(cvtpk(v1[i], 0.f) & 0xffffu);
                        }
                    }
                }
        }
    }
};

struct EpiResid {
    static constexpr bool PERM = false, AFTER_DRAIN = true;
    const float* xold_lat; const float* xold_ctx; float* xnew_lat; float* xnew_ctx;
    const float* gate;
    const float* Gnext;
    unsigned short* xg;
    float* rsq;
    DI void operator()(const f32x4 (&acc)[2][2][4][2], const Unit& u, int wr, int wc, int fr, int fq) const {}
    DI void fused(f32x4 (&acc)[2][2][4][2], const Unit& u, int wr, int wc, int fr, int fq, LAS unsigned char* lds, int wid, int lane) const {
        asm volatile("" : "+v"(fr), "+v"(fq), "+v"(lane));
        asm volatile("" : "+s"(wr), "+s"(wc), "+s"(wid));
        const int pn = u.pn, r0 = u.pm * 256;
        const int bb = r0 < NLAT ? (r0 >> 13) : 8;
        const float* xo_b = r0 < NLAT ? xold_lat + (size_t)r0 * 1024 : xold_ctx + (size_t)(r0 - NLAT) * 1024;
        float* xn_b = r0 < NLAT ? xnew_lat + (size_t)r0 * 1024 : xnew_ctx + (size_t)(r0 - NLAT) * 1024;
        const int c = 256 * pn + 4 * lane;
        const float4 g4 = *(const float4*)(gate + (size_t)bb * 1024 + c);
        float4 q4 = make_float4(0.f, 0.f, 0.f, 0.f);
        if (Gnext) q4 = *(const float4*)(Gnext + (size_t)bb * 1024 + c);
#pragma unroll
        for (int ai = 0; ai < 2; ++ai) {
            float4 xo[16];
#pragma unroll
            for (int rr = 0; rr < 8; ++rr) xo[rr] = *(const float4*)(xo_b + (size_t)(128 * ai + wid * 16 + rr) * 1024 + c);
            __builtin_amdgcn_sched_barrier(0);
#pragma unroll
            for (int m = 0; m < 4; ++m)
#pragma unroll
                for (int bj = 0; bj < 2; ++bj)
#pragma unroll
                    for (int n = 0; n < 2; ++n) {
                        const int row = 64 * wr + 16 * m + fr;
                        const int ch = 32 * bj + 8 * wc + 4 * n + fq;
                        *(LAS f32x4*)(lds + row * 1024 + ((ch ^ (row & 15)) << 4)) = acc[ai][bj][m][n];
                    }
            LDS_BARRIER();
#pragma unroll
            for (int rr = 8; rr < 16; ++rr) xo[rr] = *(const float4*)(xo_b + (size_t)(128 * ai + wid * 16 + rr) * 1024 + c);
            __builtin_amdgcn_sched_barrier(0);
            float s[16];
#pragma unroll
            for (int rr = 0; rr < 16; ++rr) {
                if (rr == 8) __builtin_amdgcn_sched_barrier(0);
                const int row = wid * 16 + rr;
                const f32x4 a4 = *(const LAS f32x4*)(lds + row * 1024 + ((lane ^ (row & 15)) << 4));
                const int rl = 128 * ai + row;
                float4 o;
                o.x = xo[rr].x + g4.x * a4[0];
                o.y = xo[rr].y + g4.y * a4[1];
                o.z = xo[rr].z + g4.z * a4[2];
                o.w = xo[rr].w + g4.w * a4[3];
                *(float4*)(xn_b + (size_t)rl * 1024 + c) = o;
                if (Gnext) {
                    uint2 pk;
                    pk.x = cvtpk(o.x * q4.x, o.y * q4.y);
                    pk.y = cvtpk(o.z * q4.z, o.w * q4.w);
                    *(uint2*)(xg + (size_t)(r0 + rl) * 1024 + c) = pk;
                }
                s[rr] = o.x * o.x + o.y * o.y + o.z * o.z + o.w * o.w;
            }
            if (rsq) {
                const bool b5 = lane & 32, b4 = lane & 16, b3 = lane & 8, b2 = lane & 4;
                float t[8], u2[4], v2[2];
#pragma unroll
                for (int j = 0; j < 8; ++j) { const float snd = b5 ? s[j] : s[j + 8]; const float kp = b5 ? s[j + 8] : s[j]; t[j] = kp + SX(snd, 32); }
#pragma unroll
                for (int j = 0; j < 4; ++j) { const float snd = b4 ? t[j] : t[j + 4]; const float kp = b4 ? t[j + 4] : t[j]; u2[j] = kp + SX(snd, 16); }
#pragma unroll
                for (int j = 0; j < 2; ++j) { const float snd = b3 ? u2[j] : u2[j + 2]; const float kp = b3 ? u2[j + 2] : u2[j]; v2[j] = kp + SX(snd, 8); }
                float tot;
                { const float snd = b2 ? v2[0] : v2[1]; const float kp = b2 ? v2[1] : v2[0]; tot = kp + SX(snd, 4); }
                tot += SX(tot, 2);
                tot += SX(tot, 1);
                const int rrow = (b5 ? 8 : 0) + (b4 ? 4 : 0) + (b3 ? 2 : 0) + (b2 ? 1 : 0);
                if ((lane & 3) == 0) atomicAdd(rsq + r0 + 128 * ai + wid * 16 + rrow, tot);
            }
            LDS_BARRIER();
        }
    }
};

struct EpiFfnin {
    static constexpr bool PERM = true, AFTER_DRAIN = false;
    char* ws; int l;
    DI void operator()(const f32x4 (&acc)[2][2][4][2], const Unit& u, int wr, int wc, int fr, int fq) const {
        asm volatile("" : "+v"(fr), "+v"(fq));
        asm volatile("" : "+s"(wr), "+s"(wc));
        const WS W{ws};
        const int pn = u.pn, r0 = u.pm * 256;
        const int bb = r0 < NLAT ? (r0 >> 13) : 8;
        const float* sh = W.shW2() + (size_t)(l * 9 + bb) * FFN2 + 256 * pn + 32 * wc + 8 * fq;
        const float* rq = W.rowsq() + (size_t)(l * 2 + 1) * NTOK + r0 + 64 * wr + fr;
        unsigned short* hid = W.hid() + (size_t)(r0 + 64 * wr + fr) * FFN + 128 * pn + 32 * wc + 8 * fq;
        float rs[2][4];
#pragma unroll
        for (int ai = 0; ai < 2; ++ai)
#pragma unroll
            for (int m = 0; m < 4; ++m) rs[ai][m] = rq[128 * ai + 16 * m];
        const float4 sg0 = *(const float4*)(sh), sg1 = *(const float4*)(sh + 4);
        const float4 su0 = *(const float4*)(sh + 128), su1 = *(const float4*)(sh + 132);
        const float sg[8] = {sg0.x, sg0.y, sg0.z, sg0.w, sg1.x, sg1.y, sg1.z, sg1.w};
        const float su[8] = {su0.x, su0.y, su0.z, su0.w, su1.x, su1.y, su1.z, su1.w};
#pragma unroll
        for (int ai = 0; ai < 2; ++ai)
#pragma unroll
            for (int m = 0; m < 4; ++m) {
                const float rstd = rsqrtf(rs[ai][m] * (1.f / 1024.f) + EPS);
                float h[8];
#pragma unroll
                for (int n = 0; n < 2; ++n)
#pragma unroll
                    for (int i = 0; i < 4; ++i) {
                        const float gg = rstd * acc[ai][0][m][n][i] + sg[4 * n + i];
                        const float uu = rstd * acc[ai][1][m][n][i] + su[4 * n + i];
                        h[4 * n + i] = silu_f(gg) * uu;
                    }
                *(uint4*)(hid + (size_t)(128 * ai + 16 * m) * FFN) = make_uint4(cvtpk(h[0], h[1]), cvtpk(h[2], h[3]), cvtpk(h[4], h[5]), cvtpk(h[6], h[7]));
            }
    }
};

struct OneUnit {
    Unit u;
    DI bool next(int i, Unit& o) const { if (i != 0) return false; o = u; return true; }
    DI void a_ready(const Unit&) const {}
    DI void done(const Unit&) const {}
};
template <class Epi>
DI void run_gemm(char* smem, const unsigned short* A, const unsigned short* Bt, int M, int N, int K, const Epi& E) {
    pg8::Gemm g;
    g.A = A; g.Bt = Bt; g.M = M; g.N = N; g.K = K;
    pg8::StaticOrder S;
    S.init(M, N, (int)gridDim.x, (int)blockIdx.x);
    __syncthreads();
    if constexpr (Epi::AFTER_DRAIN) {
        for (int i = 0;; ++i) {
            OneUnit O;
            if (!S.next(i, O.u)) break;
            pg8::gemm_phase<Epi, OneUnit, false>((LAS unsigned char*)smem, g, O, E, nullptr);
            LDS_BARRIER();
        }
    } else {
        pg8::gemm_phase<Epi, pg8::StaticOrder, false>((LAS unsigned char*)smem, g, S, E, nullptr);
    }
    __syncthreads();
}

DI float scan_sum(float v, int lane, int dir) {
#pragma unroll
    for (int d = 1; d < 64; d <<= 1) {
        float o = shfl_i(v, dir ? lane + d : lane - d);
        bool ok = dir ? (lane + d < 64) : (lane >= d);
        if (ok) v += o;
    }
    return v;
}
DI float scan_max(float v, int lane, int dir) {
#pragma unroll
    for (int d = 1; d < 64; d <<= 1) {
        float o = shfl_i(v, dir ? lane + d : lane - d);
        bool ok = dir ? (lane + d < 64) : (lane >= d);
        if (ok) v = fmaxf(v, o);
    }
    return v;
}


DI void mlstm_chain(const int wv, KP p, const int l_, const int chain, char* smem) {
    const int l = opaque_s(l_);
    const int tid = opaque_tid(wv), lane = tid & 63, w = tid >> 6, g = lane >> 5, lr = lane & 31;
    const int w4 = w & 3;
    const int tb = w4 >> 1, eb = w4 & 1;
    const bool roleA = w < 4;
    const int dir = chain & 1, head = (chain >> 1) & 3, b = chain >> 3;
    char* T = smem;
    char* Cs = smem + 65536;
    float* n_s = (float*)(smem + 81920);
    float* wgw = (float*)(smem + 82432) + w4 * 64;
    float* sc_a = (float*)(smem + 83968);
    float* sc_pm = sc_a + 8 * 64;
    float* sc_bc = sc_pm + 8 * 64;
    float* sc_be = sc_bc + 8 * 64;
    float* sc_pa = sc_be + 8;
    const int lrow = tid >> 3, lch = tid & 7;
    const WS W{p->ws};
    const float bias_i = p->gate_bias[l * 16 + dir * 8 + head];
    const float bias_f = p->gate_bias[l * 16 + dir * 8 + 4 + head];
#define CHAIN_ROWBASE(step_) ((step_) < 4 ? (NLAT + b * CTXL + (dir ? 3 - (step_) : (step_)) * 64) : (b * SEQ + (dir ? 127 - ((step_) - 4) : (step_) - 4) * 64))
#define CHAIN_PREFETCHA(step_)                                                                              \
    {                                                                                                      \
        const int pr0 = CHAIN_ROWBASE(step_);                                                              \
        const unsigned short* pq = W.P() + (size_t)(pr0 + lrow) * PSTR + head * 64 + lch * 8;              \
        rqA = *(const uint4*)(pq + C_MQ);                                                                  \
        rkA = *(const uint4*)(pq + C_MK);                                                                  \
        const size_t to = (size_t)(head * 64 + lrow) * NTOK + pr0 + lch * 8;                               \
        rktA = *(const uint4*)(W.MKT() + to);                                                              \
        rvtA = *(const uint4*)(W.MVT() + to);                                                              \
    }
#define CHAIN_PREFETCHB(step_)                                                                              \
    {                                                                                                      \
        const int pr0 = CHAIN_ROWBASE(step_);                                                              \
        const unsigned short* pq = W.P() + (size_t)(pr0 + lrow) * PSTR + head * 64 + lch * 8;              \
        rqB = *(const uint4*)(pq + C_MQ);                                                                  \
        rkB = *(const uint4*)(pq + C_MK);                                                                  \
        const size_t to = (size_t)(head * 64 + lrow) * NTOK + pr0 + lch * 8;                               \
        rktB = *(const uint4*)(W.MKT() + to);                                                              \
        rvtB = *(const uint4*)(W.MVT() + to);                                                              \
    }
#define CHAIN_TILE_STOREA(buf_)                                                                             \
    {                                                                                                      \
        char* tb_ = T + (buf_) * 32768 + lds_off(lrow, lch);                                               \
        *(uint4*)(tb_) = rqA;                                                                              \
        *(uint4*)(tb_ + 8192) = rkA;                                                                       \
        *(uint4*)(tb_ + 16384) = rktA;                                                                     \
        *(uint4*)(tb_ + 24576) = rvtA;                                                                     \
    }
#define CHAIN_TILE_STOREB(buf_)                                                                             \
    {                                                                                                      \
        char* tb_ = T + (buf_) * 32768 + lds_off(lrow, lch);                                               \
        *(uint4*)(tb_) = rqB;                                                                              \
        *(uint4*)(tb_ + 8192) = rkB;                                                                       \
        *(uint4*)(tb_ + 16384) = rktB;                                                                     \
        *(uint4*)(tb_ + 24576) = rvtB;                                                                     \
    }
#define CHAIN_GLOAD(c_)                                                                                    \
    {                                                                                                      \
        const int pr0 = CHAIN_ROWBASE(c_);                                                                 \
        g_i = W.gates()[(size_t)(pr0 + lane) * 16 + dir * 8 + head];                                       \
        g_f = W.gates()[(size_t)(pr0 + lane) * 16 + dir * 8 + 4 + head];                                   \
    }
#define CHAIN_SCAN(c_)                                                                                     \
    {                                                                                                      \
        const int sl = (c_) & 7;                                                                           \
        const float li = g_i + bias_i;                                                                     \
        const float xfg = g_f + bias_f;                                                                    \
        const float lf = fminf(xfg, 0.f) - log1pf(expf(-fabsf(xfg)));                                      \
        const float bc = scan_sum(lf, lane, dir);                                                          \
        const float a = li - bc;                                                                           \
        const float pm = scan_max(a, lane, dir);                                                           \
        sc_a[sl * 64 + lane] = a;                                                                          \
        sc_pm[sl * 64 + lane] = pm;                                                                        \
        sc_bc[sl * 64 + lane] = bc;                                                                        \
        if (lane == (dir ? 0 : 63)) { sc_be[sl] = bc; sc_pa[sl] = pm; }                                    \
    }
    float g_i = 0.f, g_f = 0.f;
    if (roleA) __builtin_amdgcn_s_setprio(3);
    uint4 rqA, rkA, rktA, rvtA, rqB, rkB, rktB, rvtB;
    __syncthreads();
    { unsigned z0 = 0u; asm volatile("" : "+v"(z0)); *(uint4*)(Cs + tid * 16) = make_uint4(z0, z0, z0, z0); }
    if (tid < 128) n_s[tid] = 0.f;
    CHAIN_PREFETCHB(0);
    if (!roleA) {
        CHAIN_GLOAD(w4);
        CHAIN_SCAN(w4);
        CHAIN_GLOAD(4 + w4);
    }
    CHAIN_TILE_STOREB(0);
    CHAIN_PREFETCHA(1);
    CHAIN_PREFETCHB(2);
    f32x16 CT;
#pragma unroll
    for (int r = 0; r < 16; ++r) CT[r] = 0.f;
    float m = 0.f;
    __syncthreads();
    for (int step0 = 0; step0 < 132; step0 += 2) {
        {
            const int step = step0;
        const int cur = step & 1, nxt = cur ^ 1;
        const int j = step & 7;
        const int r0 = CHAIN_ROWBASE(step);
        if (step + 1 < 132) CHAIN_TILE_STOREA(nxt);
        if (step + 3 < 132) CHAIN_PREFETCHA(step + 3);
        const char* Qs = T + cur * 32768;
        const char* Ks = Qs + 8192;
        const char* KTs = Qs + 16384;
        const char* VTs = Qs + 24576;
        const float* a_s = sc_a + j * 64;
        const float b_end = sc_be[j];
        const float pmall = sc_pa[j];
        const float M = fmaxf(m, pmall);
        const float decay = __expf(m - M);
        const float m_new = b_end + M;
        const int tl = tb * 32 + lr;
        if (roleA) {
            const float mm_t = fmaxf(m, sc_pm[j * 64 + tl]);
            const float bc_t = sc_bc[j * 64 + tl];
            const float w_t = __expf(m - mm_t);
            const float einv_t = __expf(-(bc_t + mm_t));
            const int us = dir ? -1 : 1;
            int xq = (tl - 4 * g) * us;
            asm volatile("" : "+v"(xq));
            bf16x8 qf[4], kf0[4], kf1[4], cf[4];
#pragma unroll
            for (int ks = 0; ks < 4; ++ks) {
                qf[ks] = lds_frag(Qs, tl, ks * 2 + g);
                kf0[ks] = lds_frag(Ks, lr, ks * 2 + g);
                kf1[ks] = lds_frag(Ks, 32 + lr, ks * 2 + g);
                cf[ks] = lds_frag(Cs + cur * 8192, eb * 32 + lr, ks * 2 + g);
            }
            __builtin_amdgcn_sched_barrier(0);
            f32x16 sT[2], itv;
#pragma unroll
            for (int r = 0; r < 16; ++r) { sT[0][r] = 0.f; sT[1][r] = 0.f; itv[r] = 0.f; }
#pragma unroll
            for (int ks = 0; ks < 4; ++ks) {
                sT[0] = MFMA(kf0[ks], qf[ks], sT[0]);
                sT[1] = MFMA(kf1[ks], qf[ks], sT[1]);
                itv = MFMA(cf[ks], qf[ks], itv);
            }
            __builtin_amdgcn_sched_barrier(0);
            float qn = 0.f;
            {
                const float* ncur = n_s + cur * 64;
#pragma unroll
                for (int ks = 0; ks < 4; ++ks) {
                    const float4 n0v = *(const float4*)(ncur + ks * 16 + g * 8);
                    const float4 n1v = *(const float4*)(ncur + ks * 16 + g * 8 + 4);
                    qn += bf2f(qf[ks][0]) * n0v.x + bf2f(qf[ks][1]) * n0v.y + bf2f(qf[ks][2]) * n0v.z + bf2f(qf[ks][3]) * n0v.w;
                    qn += bf2f(qf[ks][4]) * n1v.x + bf2f(qf[ks][5]) * n1v.y + bf2f(qf[ks][6]) * n1v.z + bf2f(qf[ks][7]) * n1v.w;
                }
                qn += SX(qn, 32);
            }
            float cs = 0.f;
            f32x16 num;
            uint2 vta[4], vtb[4];
#pragma unroll
            for (int ksl = 0; ksl < 4; ++ksl) {
                vta[ksl] = *(const uint2*)(VTs + lds_off8(eb * 32 + lr, ksl * 16 + 4 * g));
                vtb[ksl] = *(const uint2*)(VTs + lds_off8(eb * 32 + lr, ksl * 16 + 8 + 4 * g));
            }
#pragma unroll
            for (int r = 0; r < 16; ++r) num[r] = itv[r] * w_t;
#pragma unroll
            for (int sb = 0; sb < 2; ++sb) {
#pragma unroll
                for (int hh = 0; hh < 2; ++hh) {
                    uint4 pu;
                    {
                        const int s0 = sb * 32 + 16 * hh + 4 * g;
                        const float4 av = *(const float4*)(a_s + s0);
                        const float4 bv = *(const float4*)(a_s + s0 + 8);
                        const int rb = 8 * hh;
                        const float p0 = sT[sb][rb + 0] * __expf(((sb * 32 + 16 * hh + 0) * us <= xq) ? (av.x - mm_t) : -1.0e30f);
                        const float p1 = sT[sb][rb + 1] * __expf(((sb * 32 + 16 * hh + 1) * us <= xq) ? (av.y - mm_t) : -1.0e30f);
                        const float p2 = sT[sb][rb + 2] * __expf(((sb * 32 + 16 * hh + 2) * us <= xq) ? (av.z - mm_t) : -1.0e30f);
                        const float p3 = sT[sb][rb + 3] * __expf(((sb * 32 + 16 * hh + 3) * us <= xq) ? (av.w - mm_t) : -1.0e30f);
                        const float p4 = sT[sb][rb + 4] * __expf(((sb * 32 + 16 * hh + 8) * us <= xq) ? (bv.x - mm_t) : -1.0e30f);
                        const float p5 = sT[sb][rb + 5] * __expf(((sb * 32 + 16 * hh + 9) * us <= xq) ? (bv.y - mm_t) : -1.0e30f);
                        const float p6 = sT[sb][rb + 6] * __expf(((sb * 32 + 16 * hh + 10) * us <= xq) ? (bv.z - mm_t) : -1.0e30f);
                        const float p7 = sT[sb][rb + 7] * __expf(((sb * 32 + 16 * hh + 11) * us <= xq) ? (bv.w - mm_t) : -1.0e30f);
                        cs += ((p0 + p1) + (p2 + p3)) + ((p4 + p5) + (p6 + p7));
                        pu = make_uint4(cvtpk(p0, p1), cvtpk(p2, p3), cvtpk(p4, p5), cvtpk(p6, p7));
                    }
                    const int ksl = sb * 2 + hh;
                    num = MFMA(u4_to_frag(make_uint4(vta[ksl].x, vta[ksl].y, vtb[ksl].x, vtb[ksl].y)), u4_to_frag(pu), num);
                }
            }
            cs += SX(cs, 32);
            {
                const float den = w_t * qn + cs;
                const float inv = __builtin_amdgcn_rcpf(fmaxf(fabsf(den), einv_t));
                unsigned short* hp = W.hdir() + (size_t)dir * NTOK * 256 + (size_t)(r0 + tl) * 256 + head * 64 + eb * 32 + 4 * g;
#pragma unroll
                for (int jj = 0; jj < 4; ++jj) {
                    uint2 o;
                    o.x = cvtpk(num[4 * jj] * inv, num[4 * jj + 1] * inv);
                    o.y = cvtpk(num[4 * jj + 2] * inv, num[4 * jj + 3] * inv);
                    *(uint2*)(hp + 8 * jj) = o;
                }
            }
        } else {
            if ((step & 3) == w4 && step + 4 < 132) {
                CHAIN_SCAN(step + 4);
                if (step + 8 < 132) CHAIN_GLOAD(step + 8);
            }
            wgw[lane] = __expf(a_s[lane] - M);
            asm volatile("s_waitcnt lgkmcnt(0)" ::: "memory");
#pragma unroll
            for (int r = 0; r < 16; ++r) CT[r] *= decay;
            float nsum = 0.f;
            bf16x8 kfs[4], vfs[4];
            float4 w0s[4], w1s[4];
#pragma unroll
            for (int ks = 0; ks < 4; ++ks) {
                kfs[ks] = lds_frag(KTs, tb * 32 + lr, ks * 2 + g);
                vfs[ks] = lds_frag(VTs, eb * 32 + lr, ks * 2 + g);
                w0s[ks] = *(const float4*)(wgw + ks * 16 + g * 8);
                w1s[ks] = *(const float4*)(wgw + ks * 16 + g * 8 + 4);
            }
            __builtin_amdgcn_sched_barrier(0);
#pragma unroll
            for (int ks = 0; ks < 4; ++ks) {
                const bf16x8 kf = kfs[ks];
                const float4 w0 = w0s[ks];
                const float4 w1 = w1s[ks];
                float e0 = bf2f(kf[0]) * w0.x, e1 = bf2f(kf[1]) * w0.y, e2 = bf2f(kf[2]) * w0.z, e3 = bf2f(kf[3]) * w0.w;
                float e4 = bf2f(kf[4]) * w1.x, e5 = bf2f(kf[5]) * w1.y, e6 = bf2f(kf[6]) * w1.z, e7 = bf2f(kf[7]) * w1.w;
                nsum += (e0 + e1) + (e2 + e3) + (e4 + e5) + (e6 + e7);
                const uint4 ku = make_uint4(cvtpk(e0, e1), cvtpk(e2, e3), cvtpk(e4, e5), cvtpk(e6, e7));
                CT = MFMA(u4_to_frag(ku), vfs[ks], CT);
            }
            nsum += SX(nsum, 32);
            if (eb == 0 && g == 0) n_s[nxt * 64 + tb * 32 + lr] = decay * n_s[cur * 64 + tb * 32 + lr] + nsum;
#pragma unroll
            for (int jj = 0; jj < 4; ++jj) {
                uint2 o;
                o.x = cvtpk(CT[4 * jj], CT[4 * jj + 1]);
                o.y = cvtpk(CT[4 * jj + 2], CT[4 * jj + 3]);
                *(uint2*)(Cs + nxt * 8192 + lds_off8(eb * 32 + lr, tb * 32 + 8 * jj + 4 * g)) = o;
            }
        }
        m = m_new;
        asm volatile("s_waitcnt lgkmcnt(0)" ::: "memory");
        __builtin_amdgcn_s_barrier();
        asm volatile("" ::: "memory");
        }
        {
            const int step = step0 + 1;
        const int cur = step & 1, nxt = cur ^ 1;
        const int j = step & 7;
        const int r0 = CHAIN_ROWBASE(step);
        if (step + 1 < 132) CHAIN_TILE_STOREB(nxt);
        if (step + 3 < 132) CHAIN_PREFETCHB(step + 3);
        const char* Qs = T + cur * 32768;
        const char* Ks = Qs + 8192;
        const char* KTs = Qs + 16384;
        const char* VTs = Qs + 24576;
        const float* a_s = sc_a + j * 64;
        const float b_end = sc_be[j];
        const float pmall = sc_pa[j];
        const float M = fmaxf(m, pmall);
        const float decay = __expf(m - M);
        const float m_new = b_end + M;
        const int tl = tb * 32 + lr;
        if (roleA) {
            const float mm_t = fmaxf(m, sc_pm[j * 64 + tl]);
            const float bc_t = sc_bc[j * 64 + tl];
            const float w_t = __expf(m - mm_t);
            const float einv_t = __expf(-(bc_t + mm_t));
            const int us = dir ? -1 : 1;
            int xq = (tl - 4 * g) * us;
            asm volatile("" : "+v"(xq));
            bf16x8 qf[4], kf0[4], kf1[4], cf[4];
#pragma unroll
            for (int ks = 0; ks < 4; ++ks) {
                qf[ks] = lds_frag(Qs, tl, ks * 2 + g);
                kf0[ks] = lds_frag(Ks, lr, ks * 2 + g);
                kf1[ks] = lds_frag(Ks, 32 + lr, ks * 2 + g);
                cf[ks] = lds_frag(Cs + cur * 8192, eb * 32 + lr, ks * 2 + g);
            }
            __builtin_amdgcn_sched_barrier(0);
            f32x16 sT[2], itv;
#pragma unroll
            for (int r = 0; r < 16; ++r) { sT[0][r] = 0.f; sT[1][r] = 0.f; itv[r] = 0.f; }
#pragma unroll
            for (int ks = 0; ks < 4; ++ks) {
                sT[0] = MFMA(kf0[ks], qf[ks], sT[0]);
                sT[1] = MFMA(kf1[ks], qf[ks], sT[1]);
                itv = MFMA(cf[ks], qf[ks], itv);
            }
            __builtin_amdgcn_sched_barrier(0);
            float qn = 0.f;
            {
                const float* ncur = n_s + cur * 64;
#pragma unroll
                for (int ks = 0; ks < 4; ++ks) {
                    const float4 n0v = *(const float4*)(ncur + ks * 16 + g * 8);
                    const float4 n1v = *(const float4*)(ncur + ks * 16 + g * 8 + 4);
                    qn += bf2f(qf[ks][0]) * n0v.x + bf2f(qf[ks][1]) * n0v.y + bf2f(qf[ks][2]) * n0v.z + bf2f(qf[ks][3]) * n0v.w;
                    qn += bf2f(qf[ks][4]) * n1v.x + bf2f(qf[ks][5]) * n1v.y + bf2f(qf[ks][6]) * n1v.z + bf2f(qf[ks][7]) * n1v.w;
                }
                qn += SX(qn, 32);
            }
            float cs = 0.f;
            f32x16 num;
            uint2 vta[4], vtb[4];
#pragma unroll
            for (int ksl = 0; ksl < 4; ++ksl) {
                vta[ksl] = *(const uint2*)(VTs + lds_off8(eb * 32 + lr, ksl * 16 + 4 * g));
                vtb[ksl] = *(const uint2*)(VTs + lds_off8(eb * 32 + lr, ksl * 16 + 8 + 4 * g));
            }
#pragma unroll
            for (int r = 0; r < 16; ++r) num[r] = itv[r] * w_t;
#pragma unroll
            for (int sb = 0; sb < 2; ++sb) {
#pragma unroll
                for (int hh = 0; hh < 2; ++hh) {
                    uint4 pu;
                    {
                        const int s0 = sb * 32 + 16 * hh + 4 * g;
                        const float4 av = *(const float4*)(a_s + s0);
                        const float4 bv = *(const float4*)(a_s + s0 + 8);
                        const int rb = 8 * hh;
                        const float p0 = sT[sb][rb + 0] * __expf(((sb * 32 + 16 * hh + 0) * us <= xq) ? (av.x - mm_t) : -1.0e30f);
                        const float p1 = sT[sb][rb + 1] * __expf(((sb * 32 + 16 * hh + 1) * us <= xq) ? (av.y - mm_t) : -1.0e30f);
                        const float p2 = sT[sb][rb + 2] * __expf(((sb * 32 + 16 * hh + 2) * us <= xq) ? (av.z - mm_t) : -1.0e30f);
                        const float p3 = sT[sb][rb + 3] * __expf(((sb * 32 + 16 * hh + 3) * us <= xq) ? (av.w - mm_t) : -1.0e30f);
                        const float p4 = sT[sb][rb + 4] * __expf(((sb * 32 + 16 * hh + 8) * us <= xq) ? (bv.x - mm_t) : -1.0e30f);
                        const float p5 = sT[sb][rb + 5] * __expf(((sb * 32 + 16 * hh + 9) * us <= xq) ? (bv.y - mm_t) : -1.0e30f);
                        const float p6 = sT[sb][rb + 6] * __expf(((sb * 32 + 16 * hh + 10) * us <= xq) ? (bv.z - mm_t) : -1.0e30f);
                        const float p7 = sT[sb][rb + 7] * __expf(((sb * 32 + 16 * hh + 11) * us <= xq) ? (bv.w - mm_t) : -1.0e30f);
                        cs += ((p0 + p1) + (p2 + p3)) + ((p4 + p5) + (p6 + p7));
                        pu = make_uint4(cvtpk(p0, p1), cvtpk(p2, p3), cvtpk(p4, p5), cvtpk(p6, p7));
                    }
                    const int ksl = sb * 2 + hh;
                    num = MFMA(u4_to_frag(make_uint4(vta[ksl].x, vta[ksl].y, vtb[ksl].x, vtb[ksl].y)), u4_to_frag(pu), num);
                }
            }
            cs += SX(cs, 32);
            {
                const float den = w_t * qn + cs;
                const float inv = __builtin_amdgcn_rcpf(fmaxf(fabsf(den), einv_t));
                unsigned short* hp = W.hdir() + (size_t)dir * NTOK * 256 + (size_t)(r0 + tl) * 256 + head * 64 + eb * 32 + 4 * g;
#pragma unroll
                for (int jj = 0; jj < 4; ++jj) {
                    uint2 o;
                    o.x = cvtpk(num[4 * jj] * inv, num[4 * jj + 1] * inv);
                    o.y = cvtpk(num[4 * jj + 2] * inv, num[4 * jj + 3] * inv);
                    *(uint2*)(hp + 8 * jj) = o;
                }
            }
        } else {
            if ((step & 3) == w4 && step + 4 < 132) {
                CHAIN_SCAN(step + 4);
                if (step + 8 < 132) CHAIN_GLOAD(step + 8);
            }
            wgw[lane] = __expf(a_s[lane] - M);
            asm volatile("s_waitcnt lgkmcnt(0)" ::: "memory");
#pragma unroll
            for (int r = 0; r < 16; ++r) CT[r] *= decay;
            float nsum = 0.f;
            bf16x8 kfs[4], vfs[4];
            float4 w0s[4], w1s[4];
#pragma unroll
            for (int ks = 0; ks < 4; ++ks) {
                kfs[ks] = lds_frag(KTs, tb * 32 + lr, ks * 2 + g);
                vfs[ks] = lds_frag(VTs, eb * 32 + lr, ks * 2 + g);
                w0s[ks] = *(const float4*)(wgw + ks * 16 + g * 8);
                w1s[ks] = *(const float4*)(wgw + ks * 16 + g * 8 + 4);
            }
            __builtin_amdgcn_sched_barrier(0);
#pragma unroll
            for (int ks = 0; ks < 4; ++ks) {
                const bf16x8 kf = kfs[ks];
                const float4 w0 = w0s[ks];
                const float4 w1 = w1s[ks];
                float e0 = bf2f(kf[0]) * w0.x, e1 = bf2f(kf[1]) * w0.y, e2 = bf2f(kf[2]) * w0.z, e3 = bf2f(kf[3]) * w0.w;
                float e4 = bf2f(kf[4]) * w1.x, e5 = bf2f(kf[5]) * w1.y, e6 = bf2f(kf[6]) * w1.z, e7 = bf2f(kf[7]) * w1.w;
                nsum += (e0 + e1) + (e2 + e3) + (e4 + e5) + (e6 + e7);
                const uint4 ku = make_uint4(cvtpk(e0, e1), cvtpk(e2, e3), cvtpk(e4, e5), cvtpk(e6, e7));
                CT = MFMA(u4_to_frag(ku), vfs[ks], CT);
            }
            nsum += SX(nsum, 32);
            if (eb == 0 && g == 0) n_s[nxt * 64 + tb * 32 + lr] = decay * n_s[cur * 64 + tb * 32 + lr] + nsum;
#pragma unroll
            for (int jj = 0; jj < 4; ++jj) {
                uint2 o;
                o.x = cvtpk(CT[4 * jj], CT[4 * jj + 1]);
                o.y = cvtpk(CT[4 * jj + 2], CT[4 * jj + 3]);
                *(uint2*)(Cs + nxt * 8192 + lds_off8(eb * 32 + lr, tb * 32 + 8 * jj + 4 * g)) = o;
            }
        }
        m = m_new;
        asm volatile("s_waitcnt lgkmcnt(0)" ::: "memory");
        __builtin_amdgcn_s_barrier();
        asm volatile("" ::: "memory");
        }
    }
    __builtin_amdgcn_s_setprio(0);
#undef CHAIN_ROWBASE
#undef CHAIN_PREFETCHA
#undef CHAIN_PREFETCHB
#undef CHAIN_TILE_STOREA
#undef CHAIN_TILE_STOREB
#undef CHAIN_SCAN
#undef CHAIN_GLOAD
}

DI void attn_item(const int wv, KP p, const int l_, const int item, const bool isctx, char* smem) {
    const int l = opaque_s(l_);
    const int tid = opaque_tid(wv), lane = tid & 63, w = tid >> 6, g = lane >> 5, lr = lane & 31;
    const int lrow = tid >> 3, lch = tid & 7;
    const WS W{p->ws};
    int b, kvh, q0, qrow0;
    if (!isctx) { b = item >> 8; kvh = (item >> 7) & 1; q0 = (item & 127) * 64; qrow0 = b * SEQ + q0; }
    else { b = item >> 3; kvh = (item >> 2) & 1; q0 = (item & 3) * 64; qrow0 = NLAT + b * CTXL + q0; }
    const int h = kvh * 4 + (w & 3);
    const int qb = w >> 2;
    char* KV = smem;
    char* Qw = smem + 32768 + w * 4096;
    LDS_BARRIER();
#pragma unroll
    for (int i = 0; i < 4; ++i) {
        const int row = (lane >> 3) + 8 * i, ch = lane & 7;
        *(uint4*)(Qw + lds_off(row, ch)) = *(const uint4*)(W.P() + (size_t)(qrow0 + qb * 32 + row) * PSTR + C_AQ + h * 64 + ch * 8);
    }
    const float sinkv = p->sink[l * 8 + h] * 1.44269504089f;
    float mrun = sinkv;
    float lrun = g == 0 ? 1.f : 0.f;
    f32x16 O0, O1;
#pragma unroll
    for (int r = 0; r < 16; ++r) { O0[r] = 0.f; O1[r] = 0.f; }
    int kstart = 0, ntl = 0;
    if (!isctx) {
        kstart = q0 - 128 < 0 ? 0 : q0 - 128;
        int kend = q0 + 192 > SEQ ? SEQ : q0 + 192;
        ntl = (kend - kstart) >> 6;
    }
    const unsigned short* kbase = W.P() + (size_t)lrow * PSTR + C_AK + kvh * 64 + lch * 8;
    const unsigned short* vbase = W.AVT() + (size_t)(kvh * 64 + lrow) * NTOK + lch * 8;
    uint4 kr0, vr0;
    const int ntot = ntl + 4;
    {
        const int krow_first = ntl > 0 ? b * SEQ + kstart : NLAT + b * CTXL;
        kr0 = *(const uint4*)(kbase + (size_t)krow_first * PSTR);
        vr0 = *(const uint4*)(vbase + krow_first);
    }
    *(uint4*)(KV + lds_off(lrow, lch)) = kr0;
    *(uint4*)(KV + 8192 + lds_off(lrow, lch)) = vr0;
    {
        const int krow_n = (1 < ntl) ? b * SEQ + kstart + 64 : NLAT + b * CTXL + (1 - ntl) * 64;
        kr0 = *(const uint4*)(kbase + (size_t)krow_n * PSTR);
        vr0 = *(const uint4*)(vbase + krow_n);
    }
    asm volatile("s_waitcnt lgkmcnt(0)" ::: "memory");
    __builtin_amdgcn_s_barrier();
    asm volatile("" ::: "memory");
    for (int tix = 0; tix < ntot; ++tix) {
        const bool local = tix < ntl;
        const int kpos0 = kstart + tix * 64;
        const char* Ks = KV + (tix & 1) * 16384;
        const char* VTs = Ks + 8192;
        if (tix + 1 < ntot) {
            char* kn = KV + ((tix + 1) & 1) * 16384;
            *(uint4*)(kn + lds_off(lrow, lch)) = kr0;
            *(uint4*)(kn + 8192 + lds_off(lrow, lch)) = vr0;
        }
        if (tix + 2 < ntot) {
            const int krow_n = (tix + 2 < ntl) ? b * SEQ + kpos0 + 128 : NLAT + b * CTXL + (tix + 2 - ntl) * 64;
            kr0 = *(const uint4*)(kbase + (size_t)krow_n * PSTR);
            vr0 = *(const uint4*)(vbase + krow_n);
        }
#pragma unroll
        for (int kb = 0; kb < 2; ++kb) {
            if (local) {
                const int k0b = kpos0 + kb * 32, q0b = q0 + qb * 32;
                if (k0b + 31 < q0b - 128 || k0b > q0b + 31 + 128) continue;
            }
            __builtin_amdgcn_sched_barrier(0);
            f32x16 s0;
#pragma unroll
            for (int r = 0; r < 16; ++r) s0[r] = 0.f;
            bf16x8 kfa[4], qfa[4];
            uint2 va0[2], va1[2], vb0[2], vb1[2];
#pragma unroll
            for (int ks = 0; ks < 4; ++ks) { kfa[ks] = lds_frag(Ks, kb * 32 + lr, ks * 2 + g); qfa[ks] = lds_frag(Qw, lr, ks * 2 + g); }
#pragma unroll
            for (int hh = 0; hh < 2; ++hh) {
                const int ksl = kb * 2 + hh;
                va0[hh] = *(const uint2*)(VTs + lds_off8(lr, ksl * 16 + 4 * g));
                va1[hh] = *(const uint2*)(VTs + lds_off8(lr, ksl * 16 + 8 + 4 * g));
                vb0[hh] = *(const uint2*)(VTs + lds_off8(32 + lr, ksl * 16 + 4 * g));
                vb1[hh] = *(const uint2*)(VTs + lds_off8(32 + lr, ksl * 16 + 8 + 4 * g));
            }
            __builtin_amdgcn_sched_barrier(0);
#pragma unroll
            for (int ks = 0; ks < 4; ++ks) s0 = MFMA(kfa[ks], qfa[ks], s0);
            if (local && (kpos0 < q0 - 64 || kpos0 > q0 + 64)) {
                const int dq = q0 + qb * 32 + lr - (kpos0 + kb * 32 + 4 * g);
#pragma unroll
                for (int r = 0; r < 16; ++r) {
                    const int d0 = dq - ((r & 3) + 8 * (r >> 2));
                    s0[r] = ((d0 <= 128) && (d0 >= -128)) ? s0[r] : -1.0e30f;
                }
            }
            float tmax = s0[0];
#pragma unroll
            for (int r = 1; r < 16; ++r) tmax = fmaxf(tmax, s0[r]);
            tmax = fmaxf(tmax, SX(tmax, 32));
            const float mnew = fmaxf(mrun, tmax);
            const float alpha = __builtin_amdgcn_exp2f(mrun - mnew);
            float ls = 0.f;
#pragma unroll
            for (int r = 0; r < 16; ++r) {
                s0[r] = __builtin_amdgcn_exp2f(s0[r] - mnew);
                ls += s0[r];
            }
            mrun = mnew;
            lrun = lrun * alpha + ls;
            if (__any(alpha != 1.f)) {
#pragma unroll
                for (int r = 0; r < 16; ++r) { O0[r] *= alpha; O1[r] *= alpha; }
            }
#pragma unroll
            for (int hh = 0; hh < 2; ++hh) {
                const uint4 pu = make_uint4(cvtpk(s0[8 * hh + 0], s0[8 * hh + 1]), cvtpk(s0[8 * hh + 2], s0[8 * hh + 3]), cvtpk(s0[8 * hh + 4], s0[8 * hh + 5]), cvtpk(s0[8 * hh + 6], s0[8 * hh + 7]));
                const bf16x8 pf = u4_to_frag(pu);
                O0 = MFMA(u4_to_frag(make_uint4(va0[hh].x, va0[hh].y, va1[hh].x, va1[hh].y)), pf, O0);
                O1 = MFMA(u4_to_frag(make_uint4(vb0[hh].x, vb0[hh].y, vb1[hh].x, vb1[hh].y)), pf, O1);
            }
        }
        asm volatile("s_waitcnt lgkmcnt(0)" ::: "memory");
        __builtin_amdgcn_s_barrier();
        asm volatile("" ::: "memory");
    }
    {
        const float lt = lrun + SX(lrun, 32);
        const float inv = 1.f / lt;
        unsigned short* op = W.mix() + (size_t)(qrow0 + qb * 32 + lr) * 1024 + 256 + h * 64 + 4 * g;
#pragma unroll
        for (int j = 0; j < 4; ++j) {
            uint2 o;
            o.x = cvtpk(O0[4 * j] * inv, O0[4 * j + 1] * inv);
            o.y = cvtpk(O0[4 * j + 2] * inv, O0[4 * j + 3] * inv);
            *(uint2*)(op + 8 * j) = o;
            o.x = cvtpk(O1[4 * j] * inv, O1[4 * j + 1] * inv);
            o.y = cvtpk(O1[4 * j + 2] * inv, O1[4 * j + 3] * inv);
            *(uint2*)(op + 32 + 8 * j) = o;
        }
    }
}

DI void conv_item(const int wv, KP p, const int l_, const int item, const bool isctx, char* smem) {
    const int l = opaque_s(l_);
    const int tid = opaque_tid(wv), lane = tid & 63, w = tid >> 6;
    const int c = tid & 255, half = tid >> 8;
    const WS W{p->ws};
    int rowbase, L, t0;
    if (!isctx) { const int b = item >> 7; rowbase = b * SEQ; L = SEQ; t0 = (item & 127) * 64; }
    else { const int b = item >> 2; rowbase = NLAT + b * CTXL; L = CTXL; t0 = (item & 3) * 64; }
    float* ys = (float*)smem;
    LDS_BARRIER();
    for (int u = tid; u < 94 * 32; u += 512) {
        const int rr = u >> 5, c8 = (u & 31) * 8;
        const int t = t0 - 15 + rr;
        float y[8];
        if (t >= 0 && t < L) {
            const uint4 av = *(const uint4*)(W.P() + (size_t)(rowbase + t) * PSTR + C_CV + c8);
            const uint4 gv = *(const uint4*)(W.P() + (size_t)(rowbase + t) * PSTR + C_CV + 256 + c8);
            y[0] = bflo(av.x) * sigmoid_f(bflo(gv.x)); y[1] = bfhi(av.x) * sigmoid_f(bfhi(gv.x));
            y[2] = bflo(av.y) * sigmoid_f(bflo(gv.y)); y[3] = bfhi(av.y) * sigmoid_f(bfhi(gv.y));
            y[4] = bflo(av.z) * sigmoid_f(bflo(gv.z)); y[5] = bfhi(av.z) * sigmoid_f(bfhi(gv.z));
            y[6] = bflo(av.w) * sigmoid_f(bflo(gv.w)); y[7] = bfhi(av.w) * sigmoid_f(bfhi(gv.w));
        } else {
#pragma unroll
            for (int i = 0; i < 8; ++i) y[i] = 0.f;
        }
        *(float4*)(ys + rr * 256 + c8) = make_float4(y[0], y[1], y[2], y[3]);
        *(float4*)(ys + rr * 256 + c8 + 4) = make_float4(y[4], y[5], y[6], y[7]);
    }
    float wj[31];
#pragma unroll
    for (int j = 0; j < 31; ++j) wj[j] = p->dw_w[(size_t)l * 31 * 256 + j * 256 + c];
    const float bias = p->dw_b[l * 256 + c];
    LDS_BARRIER();
    float z[32];
#pragma unroll
    for (int t = 0; t < 32; ++t) z[t] = bias;
    const float* ysh = ys + half * 32 * 256 + c;
#pragma unroll
    for (int rr = 0; rr < 62; ++rr) {
        const float yv = ysh[rr * 256];
#pragma unroll
        for (int t = 0; t < 32; ++t) {
            const int j = rr - t;
            if (j >= 0 && j < 31) z[t] += yv * wj[j];
        }
    }
    LDS_BARRIER();
#pragma unroll
    for (int t = 0; t < 32; ++t) ys[(half * 32 + t) * 256 + c] = z[t];
    LDS_BARRIER();
    const float4 lg = *(const float4*)(p->ln_g + l * 256 + lane * 4);
    const float4 lb = *(const float4*)(p->ln_b + l * 256 + lane * 4);
#pragma unroll
    for (int q = 0; q < 8; ++q) {
        const int t = w * 8 + q;
        const float4 zv = *(const float4*)(ys + t * 256 + lane * 4);
        float s = zv.x + zv.y + zv.z + zv.w;
#pragma unroll
        for (int o = 32; o >= 1; o >>= 1) s += SX(s, o);
        const float mu = s * (1.f / 256.f);
        const float d0 = zv.x - mu, d1 = zv.y - mu, d2 = zv.z - mu, d3 = zv.w - mu;
        float v = d0 * d0 + d1 * d1 + d2 * d2 + d3 * d3;
#pragma unroll
        for (int o = 32; o >= 1; o >>= 1) v += SX(v, o);
        const float rstd = rsqrtf(v * (1.f / 256.f) + EPS);
        const float o0 = silu_f(d0 * rstd * lg.x + lb.x), o1 = silu_f(d1 * rstd * lg.y + lb.y);
        const float o2 = silu_f(d2 * rstd * lg.z + lb.z), o3 = silu_f(d3 * rstd * lg.w + lb.w);
        uint2 o;
        o.x = cvtpk(o0, o1);
        o.y = cvtpk(o2, o3);
        *(uint2*)(W.mix() + (size_t)(rowbase + t0 + t) * 1024 + 768 + lane * 4) = o;
    }
}

DI void phase_mixers(const int wv, KP p, const int l, char* smem) {
    const int n_chain = 64;
    const int n_al = NB * 2 * 128;
    const int n_ac = (l == 0) ? NB * 2 * 4 : 0;
    const int n_cl = NB * 128;
    const int n_cc = (l == 0) ? NB * 4 : 0;
    const int total = n_chain + n_al + n_ac + n_cl + n_cc;
    int* slot = (int*)(smem + MISC_OFF + 64);
    const bool t0 = opaque_tid(wv) == 0;
    int nxt_item = 0;
    if (t0) nxt_item = (int)atomicAdd(WS{p->ws}.ctr() + l, 1u);
    for (;;) {
        LDS_BARRIER();
        if (t0) *slot = nxt_item;
        LDS_BARRIER();
        int it = *slot;
        if (it >= total) break;
        if (it < n_chain) {
            mlstm_chain(wv, p, l, it, smem);
            if (t0) nxt_item = (int)atomicAdd(WS{p->ws}.ctr() + l, 1u);
            continue;
        }
        if (t0) nxt_item = (int)atomicAdd(WS{p->ws}.ctr() + l, 1u);
        it -= n_chain;
        if (it < n_al) { attn_item(wv, p, l, it, false, smem); continue; }
        it -= n_al;
        if (it < n_ac) { attn_item(wv, p, l, it, true, smem); continue; }
        it -= n_ac;
        if (it < n_cl) { conv_item(wv, p, l, it, false, smem); continue; }
        it -= n_cl;
        conv_item(wv, p, l, it, true, smem);
    }
}

DI void phase_mfinal(const int wv, KP p, const int l) {
    const int tid = opaque_tid(wv);
    const int lane = tid & 63;
    const WS W{p->ws};
    const int nrows = (l == 0) ? NTOK : NLAT;
    const int rsub = tid >> 5, c8 = (tid & 31) * 8;
    const float4 g0 = *(const float4*)(p->head_gain + l * 256 + c8);
    const float4 g1 = *(const float4*)(p->head_gain + l * 256 + c8 + 4);
    const float gg[8] = {g0.x, g0.y, g0.z, g0.w, g1.x, g1.y, g1.z, g1.w};
    for (int rb = blockIdx.x; rb < nrows / 16; rb += gridDim.x) {
        const int r = rb * 16 + rsub;
        const uint4 a = *(const uint4*)(W.hdir() + (size_t)r * 256 + c8);
        const uint4 b = *(const uint4*)(W.hdir() + (size_t)NTOK * 256 + (size_t)r * 256 + c8);
        const uint4 ov = *(const uint4*)(W.P() + (size_t)r * PSTR + C_MO + c8);
        float hv[8], o8[8];
        hv[0] = bflo(a.x) + bflo(b.x); hv[1] = bfhi(a.x) + bfhi(b.x);
        hv[2] = bflo(a.y) + bflo(b.y); hv[3] = bfhi(a.y) + bfhi(b.y);
        hv[4] = bflo(a.z) + bflo(b.z); hv[5] = bfhi(a.z) + bfhi(b.z);
        hv[6] = bflo(a.w) + bflo(b.w); hv[7] = bfhi(a.w) + bfhi(b.w);
        o8[0] = bflo(ov.x); o8[1] = bfhi(ov.x); o8[2] = bflo(ov.y); o8[3] = bfhi(ov.y);
        o8[4] = bflo(ov.z); o8[5] = bfhi(ov.z); o8[6] = bflo(ov.w); o8[7] = bfhi(ov.w);
        float s = 0.f;
#pragma unroll
        for (int i = 0; i < 8; ++i) s += hv[i] * hv[i];
        s += SX(s, 1);
        s += SX(s, 2);
        s += SX(s, 4);
        const float rstd = rsqrtf(s * (1.f / 64.f) + EPS);
        float y[8];
#pragma unroll
        for (int i = 0; i < 8; ++i) y[i] = hv[i] * rstd * gg[i] * sigmoid_f(o8[i]);
        *(uint4*)(W.mix() + (size_t)r * 1024 + c8) = make_uint4(cvtpk(y[0], y[1]), cvtpk(y[2], y[3]), cvtpk(y[4], y[5]), cvtpk(y[6], y[7]));
    }
}

DI void phase_final(const int wv, KP p) {
    const int tid = opaque_tid(wv), lane = tid & 63, w = tid >> 6;
    for (int rb = blockIdx.x; rb < NLAT / 8; rb += gridDim.x) {
        const int r = rb * 8 + w;
        float* xp = p->out + (size_t)r * 1024;
        float4 v[4];
        float s = 0.f;
#pragma unroll
        for (int i = 0; i < 4; ++i) {
            v[i] = *(const float4*)(xp + i * 256 + lane * 4);
            s += v[i].x * v[i].x + v[i].y * v[i].y + v[i].z * v[i].z + v[i].w * v[i].w;
        }
#pragma unroll
        for (int o = 32; o >= 1; o >>= 1) s += SX(s, o);
        const float rstd = rsqrtf(s * (1.f / 1024.f) + EPS);
#pragma unroll
        for (int i = 0; i < 4; ++i) {
            const float4 gn = *(const float4*)(p->final_gain + i * 256 + lane * 4);
            *(float4*)(xp + i * 256 + lane * 4) = make_float4(v[i].x * rstd * gn.x, v[i].y * rstd * gn.y, v[i].z * rstd * gn.z, v[i].w * rstd * gn.w);
        }
    }
}

__global__ void __launch_bounds__(512, 2) fwd_megakernel(Params p_unused) {
    extern __shared__ __attribute__((aligned(16))) char smem[];
    cg::grid_group grid = cg::this_grid();
    const int wv = __builtin_amdgcn_readfirstlane((int)(threadIdx.x >> 6));
    volatile LAS unsigned* misc = (volatile LAS unsigned*)((LAS char*)smem + MISC_OFF);
    if (threadIdx.x < 16) misc[threadIdx.x] = 0u;
    __syncthreads();
    const KP p0 = (KP)__builtin_amdgcn_kernarg_segment_ptr();
    (void)xcd_barrier_post(WS{p0->ws}.bar(), misc);
#define GRID_BAR() do { XcdBarrier bar_; bar_.bar = WS{opaque_kp(p0)->ws}.bar(); bar_.x = xb_xcc_id(); bar_.st = (volatile LAS unsigned*)((LAS char*)smem + MISC_OFF); xcd_barrier(bar_, opaque_tid(wv) == 0); } while (0)
    phase0a(wv, opaque_kp(p0), smem);
    if (p0->ws == nullptr) grid.sync();
    GRID_BAR();
    phase0c(wv, opaque_kp(p0), smem);
    GRID_BAR();
#pragma unroll 1
    for (int l = 0; l < 2; ++l) {
        const int M = (l == 0) ? NTOK : NLAT;
        {
            const KP p = opaque_kp(p0);
            const WS W{p->ws};
            EpiInproj E; E.ws = p->ws; E.l = l;
            run_gemm(smem, W.xg(), W.WtIn() + (size_t)l * NP * 1024, NTOK, NP, 1024, E);
        }
        GRID_BAR();
        phase_mixers(wv, opaque_kp(p0), l, smem);
        GRID_BAR();
        phase_mfinal(wv, opaque_kp(p0), l);
        GRID_BAR();
        {
            const KP p = opaque_kp(p0);
            const WS W{p->ws};
            EpiResid E;
            E.xold_lat = (l == 0) ? p->x : p->out; E.xold_ctx = (l == 0) ? p->ctx : W.ctxa();
            E.xnew_lat = p->out; E.xnew_ctx = W.ctxa();
            E.gate = W.modv() + (size_t)((l * 6 + 2) * 9) * 1024;
            E.Gnext = W.modv() + (size_t)((l * 6 + 4) * 9) * 1024;
            E.xg = W.xg();
            E.rsq = W.rowsq() + (size_t)(l * 2 + 1) * NTOK;
            run_gemm(smem, W.mix(), W.WtOut() + (size_t)l * 1024 * 1024, M, 1024, 1024, E);
        }
        GRID_BAR();
        {
            const KP p = opaque_kp(p0);
            const WS W{p->ws};
            EpiFfnin E; E.ws = p->ws; E.l = l;
            run_gemm(smem, W.xg(), W.WtF1() + (size_t)l * FFN2 * 1024, M, FFN2, 1024, E);
        }
        GRID_BAR();
        {
            const KP p = opaque_kp(p0);
            const WS W{p->ws};
            EpiResid E;
            E.xold_lat = p->out; E.xold_ctx = W.ctxa();
            E.xnew_lat = p->out; E.xnew_ctx = W.ctxa();
            E.gate = W.modv() + (size_t)((l * 6 + 5) * 9) * 1024;
            E.Gnext = (l == 0) ? W.modv() + (size_t)((1 * 6 + 1) * 9) * 1024 : nullptr;
            E.xg = W.xg();
            E.rsq = (l == 0) ? W.rowsq() + (size_t)2 * NTOK : nullptr;
            run_gemm(smem, W.hid(), W.WtF2() + (size_t)l * 1024 * FFN, M, 1024, FFN, E);
        }
        GRID_BAR();
    }
    phase_final(wv, opaque_kp(p0));
}

extern "C" void kernel_launch(void* const* d_in, const int* in_sizes, int n_in, void* d_out, int out_size, void* d_ws,
                              size_t ws_size, hipStream_t stream) {
    static int grid_blocks = 0;
    if (!grid_blocks) {
        int dev = 0, cus = 0;
        (void)hipGetDevice(&dev);
        (void)hipDeviceGetAttribute(&cus, hipDeviceAttributeMultiprocessorCount, dev);
        if (hipFuncSetAttribute((const void*)fwd_megakernel, hipFuncAttributeMaxDynamicSharedMemorySize, LDS_BYTES) != hipSuccess)
            fprintf(stderr, "hipFuncSetAttribute(MaxDynamicSharedMemorySize) failed\n");
        int per_cu = 0;
        if (hipOccupancyMaxActiveBlocksPerMultiprocessor(&per_cu, (const void*)fwd_megakernel, 512, LDS_BYTES) != hipSuccess || per_cu < 1)
            fprintf(stderr, "occupancy query says %d blocks per CU\n", per_cu);
        (void)hipGetLastError();
        grid_blocks = cus > 0 ? cus : 256;
    }
    Params p{};
    p.x = (const float*)d_in[0]; p.c = (const float*)d_in[1]; p.ctx = (const float*)d_in[2]; p.c_ctx = (const float*)d_in[3];
    p.w_mod = (const float*)d_in[4]; p.b_mod = (const float*)d_in[5]; p.norm_gain = (const float*)d_in[6]; p.w_in = (const float*)d_in[7];
    p.gate_bias = (const float*)d_in[8]; p.head_gain = (const float*)d_in[9]; p.sink = (const float*)d_in[10];
    p.dw_w = (const float*)d_in[11]; p.dw_b = (const float*)d_in[12]; p.ln_g = (const float*)d_in[13]; p.ln_b = (const float*)d_in[14];
    p.pw_w = (const float*)d_in[15]; p.w_out = (const float*)d_in[16]; p.w_ffn_in = (const float*)d_in[17]; p.w_ffn_out = (const float*)d_in[18];
    p.final_gain = (const float*)d_in[19];
    p.out = (float*)d_out;
    p.ws = (char*)d_ws;
    if (O_END > ws_size) fprintf(stderr, "workspace too small: need %zu have %zu\n", (size_t)O_END, ws_size);
    (void)hipMemsetAsync((char*)d_ws + O_CTR, 0, (O_ROWSQ - O_CTR) + (size_t)5 * NTOK * 4, stream);
    void* args[] = {&p};
    hipError_t e = hipLaunchCooperativeKernel((void*)fwd_megakernel, dim3(grid_blocks), dim3(512), args, LDS_BYTES, stream);
    if (e != hipSuccess) fprintf(stderr, "cooperative launch failed: %s (grid %d)\n", hipGetErrorString(e), grid_blocks);
}
```

```cpp
#include <hip/hip_runtime.h>
#include <hip/hip_cooperative_groups.h>
#include <cstdio>
#include <cstdint>
namespace cg = cooperative_groups;

#define DI __device__ __forceinline__
typedef __attribute__((ext_vector_type(8))) short bf16x8;
typedef __attribute__((ext_vector_type(16))) float f32x16;
#define MFMA(a, b, c) __builtin_amdgcn_mfma_f32_32x32x16_bf16((a), (b), (c), 0, 0, 0)

constexpr int DM = 1024;
constexpr int NB = 8;
constexpr int SEQ = 8192;
constexpr int CTXL = 256;
constexpr int NLAT = NB * SEQ;
constexpr int NCTX = NB * CTXL;
constexpr int NTOK = NLAT + NCTX;
constexpr int INC = 2320;
constexpr int NP = 2560;
constexpr int PSTR = 2304;
constexpr int FFN = 2816;
constexpr int FFN2 = 5632;
constexpr int C_MQ = 0, C_MK = 256, C_MV = 512, C_MO = 768, C_AQ = 1024, C_AK = 1536, C_AV = 1664, C_CV = 1792;
constexpr float EPS = 1e-6f;

constexpr size_t al256(size_t v) { return (v + 255) & ~(size_t)255; }
constexpr size_t O_WTIN = 0;
constexpr size_t O_WTOUT = O_WTIN + al256((size_t)2 * NP * 1024 * 2);
constexpr size_t O_WTF1 = O_WTOUT + al256((size_t)2 * 1024 * 1024 * 2);
constexpr size_t O_WTF2 = O_WTF1 + al256((size_t)2 * FFN2 * 1024 * 2);
constexpr size_t O_MODV = O_WTF2 + al256((size_t)2 * 1024 * FFN * 2);
constexpr size_t O_SHW1 = O_MODV + al256((size_t)2 * 6 * 9 * 1024 * 4);
constexpr size_t O_SHW2 = O_SHW1 + al256((size_t)2 * 9 * NP * 4);
constexpr size_t O_ROPE = O_SHW2 + al256((size_t)2 * 9 * FFN2 * 4);
constexpr size_t O_CTR = O_ROPE + al256((size_t)128 * 16 * 2 * 4);
constexpr size_t O_BAR = O_CTR + 256;
constexpr size_t O_ROWSQ = O_BAR + 16384;
constexpr size_t O_XG = O_ROWSQ + al256((size_t)5 * NTOK * 4);
constexpr size_t O_CTXA = O_XG + al256((size_t)NTOK * 1024 * 2);
constexpr size_t O_MIX = O_CTXA + al256((size_t)NCTX * 1024 * 4);
constexpr size_t O_P = O_MIX + al256((size_t)NTOK * 1024 * 2);
constexpr size_t O_MKT = O_P + al256((size_t)NTOK * PSTR * 2);
constexpr size_t O_MVT = O_MKT + al256((size_t)256 * NTOK * 2);
constexpr size_t O_AVT = O_MVT + al256((size_t)256 * NTOK * 2);
constexpr size_t O_GATES = O_AVT + al256((size_t)128 * NTOK * 2);
constexpr size_t O_HDIR = O_GATES + al256((size_t)NTOK * 16 * 4);
constexpr size_t O_END = O_HDIR + al256((size_t)2 * NTOK * 256 * 2);
constexpr size_t O_HID = O_P;
static_assert(O_HID + (size_t)NTOK * FFN * 2 <= O_END, "hid alias overflow");

struct Params {
    const float *x, *c, *ctx, *c_ctx, *w_mod, *b_mod, *norm_gain, *w_in, *gate_bias, *head_gain, *sink,
        *dw_w, *dw_b, *ln_g, *ln_b, *pw_w, *w_out, *w_ffn_in, *w_ffn_out, *final_gain;
    float* out;
    char* ws;
};
typedef const Params __attribute__((address_space(4)))* KP;
DI KP opaque_kp(KP q) { asm volatile("" : "+s"(q)); return q; }
struct WS {
    char* b;
    DI unsigned short* WtIn() const { return (unsigned short*)(b + O_WTIN); }
    DI unsigned short* WtOut() const { return (unsigned short*)(b + O_WTOUT); }
    DI unsigned short* WtF1() const { return (unsigned short*)(b + O_WTF1); }
    DI unsigned short* WtF2() const { return (unsigned short*)(b + O_WTF2); }
    DI float* modv() const { return (float*)(b + O_MODV); }
    DI float* shW1() const { return (float*)(b + O_SHW1); }
    DI float* shW2() const { return (float*)(b + O_SHW2); }
    DI float* rope() const { return (float*)(b + O_ROPE); }
    DI unsigned* ctr() const { return (unsigned*)(b + O_CTR); }
    DI unsigned* bar() const { return (unsigned*)(b + O_BAR); }
    DI float* rowsq() const { return (float*)(b + O_ROWSQ); }
    DI unsigned short* xg() const { return (unsigned short*)(b + O_XG); }
    DI float* ctxa() const { return (float*)(b + O_CTXA); }
    DI unsigned short* mix() const { return (unsigned short*)(b + O_MIX); }
    DI unsigned short* P() const { return (unsigned short*)(b + O_P); }
    DI unsigned short* MKT() const { return (unsigned short*)(b + O_MKT); }
    DI unsigned short* MVT() const { return (unsigned short*)(b + O_MVT); }
    DI unsigned short* AVT() const { return (unsigned short*)(b + O_AVT); }
    DI float* gates() const { return (float*)(b + O_GATES); }
    DI unsigned short* hdir() const { return (unsigned short*)(b + O_HDIR); }
    DI unsigned short* hid() const { return (unsigned short*)(b + O_HID); }
};

DI int opaque_tid(int wv) { int t = wv * 64 + (int)__builtin_amdgcn_mbcnt_hi(~0u, __builtin_amdgcn_mbcnt_lo(~0u, 0u)); asm volatile("" : "+v"(t)); return t; }
DI int opaque_s(int v) { asm volatile("" : "+s"(v)); return v; }
DI unsigned cvtpk(float lo, float hi) { unsigned r; asm("v_cvt_pk_bf16_f32 %0, %1, %2" : "=v"(r) : "v"(lo), "v"(hi)); return r; }
DI float bflo(unsigned u) { return __uint_as_float(u << 16); }
DI float bfhi(unsigned u) { return __uint_as_float(u & 0xffff0000u); }
DI float bf2f(short s) { return __uint_as_float(((unsigned)(unsigned short)s) << 16); }
DI int lds_off(int row, int chunk) { return row * 128 + ((chunk ^ ((row >> 1) & 7)) << 4); }
DI int lds_off8(int row, int k) { return row * 128 + ((((k >> 3)) ^ ((row >> 1) & 7)) << 4) + ((k & 7) << 1); }
DI bf16x8 lds_frag(const char* base, int row, int chunk) { return *(const bf16x8*)(base + lds_off(row, chunk)); }
DI bf16x8 u4_to_frag(uint4 v) { return __builtin_bit_cast(bf16x8, v); }
DI float shfl_i(float v, int srclane) { return __int_as_float(__builtin_amdgcn_ds_bpermute(srclane << 2, __float_as_int(v))); }
#define SX(v, m) shfl_i((v), lane ^ (m))
#define LDS_BARRIER() do { asm volatile("s_waitcnt lgkmcnt(0)" ::: "memory"); __builtin_amdgcn_s_barrier(); asm volatile("" ::: "memory"); } while (0)
DI float silu_f(float v) { return v * __builtin_amdgcn_rcpf(1.f + __expf(-v)); }
DI float sigmoid_f(float v) { return __builtin_amdgcn_rcpf(1.f + __expf(-v)); }


namespace pg8 {
#define PG8_LAS __attribute__((address_space(3)))
typedef unsigned short bf16_t;
typedef short bf16x8 __attribute__((ext_vector_type(8)));
typedef float f32x4 __attribute__((ext_vector_type(4)));
typedef unsigned u32x4 __attribute__((ext_vector_type(4)));
constexpr int BM = 256, BK = 64, HALF = 128, HTB = HALF * BK * 2  , STAGE_BYTES = 8 * HTB, NXCD = 8, WGM = 8;

__host__ __device__ __forceinline__ int lds_byte(int r, int c) { const int st = (r >> 4) * 2 + (c >> 5), rr = r & 15, cc = c & 31, ob = rr * 64 + cc * 2; return st * 1024 + (ob ^ (((ob >> 9) & 1) << 5)); }
__host__ __device__ __forceinline__ void stage_rc(int b, int& R, int& C) { const int st = b / 1024, sb = b % 1024, swz = sb ^ (((sb >> 9) & 1) << 5); R = (st >> 1) * 16 + swz / 64; C = (st & 1) * 32 + (swz % 64) / 2; }
__host__ __device__ __forceinline__ int perm32(int rho) { const int n = rho >> 4, i = rho & 15; return 8 * (i >> 2) + 4 * n + (i & 3); }

struct Unit { int pm, pn; };
struct Gemm { const bf16_t* A; const bf16_t* Bt; int M, N, K; };

struct StaticOrder {
    int nM, nN, nwg, G, c;
    __host__ __device__ void init(int M, int N, int G_, int c_) { nM = M / BM; nN = N / BM; nwg = nM * nN; G = G_; c = c_; }
    __host__ __device__ bool next(int i, Unit& u) const {
        const long L = (long)i * G + c; if (L >= nwg) return false;
        int wgid = (int)L; { const int q = nwg / NXCD, r = nwg % NXCD, xcd = wgid % NXCD, off = wgid / NXCD; wgid = (xcd < r ? xcd * (q + 1) : r * (q + 1) + (xcd - r) * q) + off; }
        const int nig = WGM * nN, gid = wgid / nig, fm = gid * WGM, gsz = (nM - fm) < WGM ? (nM - fm) : WGM;
        u.pm = fm + ((wgid % nig) % gsz); u.pn = (wgid % nig) / gsz; return true;
    }
    __device__ __forceinline__ void a_ready(const Unit&) const {}
    __device__ __forceinline__ void done(const Unit&) const {}
};
template <class Epi, class Sched, bool STAMP = false>
__device__ __forceinline__ void gemm_phase(PG8_LAS unsigned char* lds, const Gemm g, const Sched& S, const Epi& E, unsigned long long* stamps) {
    int tid_o = threadIdx.x; asm volatile("" : "+v"(tid_o));
    const int tid = tid_o, wid = __builtin_amdgcn_readfirstlane(tid >> 6), lane = tid & 63, wr = wid >> 2, wc = wid & 3, fr = lane & 15, fq = lane >> 4;
    const int K = g.K, nt = K / BK;
    int ts_lo = 0, ts_hi = 0, nts = 0; const unsigned long long rt_entry = STAMP ? (unsigned long long)wall_clock64() : 0ull;
#define PG8_STAMP() do { if (STAMP && wid == 0 && nts < 64) { const unsigned long long _c = (unsigned long long)clock64(); \
        ts_lo = (lane == nts) ? (int)(unsigned)_c : ts_lo; ts_hi = (lane == nts) ? (int)(unsigned)(_c >> 32) : ts_hi; ++nts; } } while (0)
    PG8_STAMP();
    unsigned voffA[2], voffB[2];
#pragma unroll
    for (int i = 0; i < 2; ++i) { int R, C; stage_rc(tid * 16 + i * 8192, R, C); const int Rb = Epi::PERM ? ((R & ~31) + perm32(R & 31)) : R;
        voffA[i] = (unsigned)(R * K + C) * 2u; voffB[i] = (unsigned)(Rb * K + C) * 2u; }
    const size_t kstep = (size_t)(BK * 2);
    const size_t hstep = (size_t)HALF * K * 2;
    const size_t tstep = 2 * hstep;
    const unsigned ldsw = (unsigned)wid * 1024u;
    const int aoff = lds_byte(wr * 64 + fr, fq * 8), boff = lds_byte(wc * 32 + fr, fq * 8);
#define PG8_SA(b, h) (((b) * 2 + (h)) * HTB)
#define PG8_SB(b, h) ((4 + (b) * 2 + (h)) * HTB)
#define PG8_STAGE(bufoff, gbase, voff) do { _Pragma("unroll") for (int _i = 0; _i < 2; ++_i) \
        __builtin_amdgcn_global_load_lds((const unsigned*)((const char*)(gbase) + (voff)[_i]), (PG8_LAS unsigned*)(lds + (bufoff) + ldsw + _i * 8192), 16, 0, 0); } while (0)
#define PG8_LDA(dst, b, h) do { _Pragma("unroll") for (int m = 0; m < 4; ++m) _Pragma("unroll") for (int k = 0; k < 2; ++k) dst[m][k] = *(const PG8_LAS bf16x8*)(lds + PG8_SA(b, h) + aoff + m * 2048 + k * 1024); } while (0)
#define PG8_LDB(dst, b, h) do { _Pragma("unroll") for (int n = 0; n < 2; ++n) _Pragma("unroll") for (int k = 0; k < 2; ++k) dst[n][k] = *(const PG8_LAS bf16x8*)(lds + PG8_SB(b, h) + boff + n * 2048 + k * 1024); } while (0)
#define PG8_MMA(ai, bj, At, Bt) do { __builtin_amdgcn_s_setprio(1); _Pragma("unroll") for (int m = 0; m < 4; ++m) _Pragma("unroll") for (int n = 0; n < 2; ++n) _Pragma("unroll") for (int k = 0; k < 2; ++k) \
        acc[ai][bj][m][n] = __builtin_amdgcn_mfma_f32_16x16x32_bf16(Bt[n][k], At[m][k], acc[ai][bj][m][n], 0, 0, 0); __builtin_amdgcn_s_setprio(0); } while (0)
#define PG8_WAIT_V(n) asm volatile("s_waitcnt vmcnt(" #n ")" ::: "memory")
#define PG8_WAIT_L(n) asm volatile("s_waitcnt lgkmcnt(" #n ")" ::: "memory")
#define PG8_BAR __builtin_amdgcn_s_barrier()
#define PG8_SCHED __builtin_amdgcn_sched_barrier(0)
    Unit cur, nxt; int ui = 0;
    if (!S.next(0, cur)) return;
    f32x4 acc[2][2][4][2];
#pragma unroll
    for (int a = 0; a < 2; ++a)
#pragma unroll
        for (int b = 0; b < 2; ++b)
#pragma unroll
            for (int m = 0; m < 4; ++m)
#pragma unroll
                for (int n = 0; n < 2; ++n) acc[a][b][m][n] = (f32x4){0.f, 0.f, 0.f, 0.f};
    bf16x8 At[4][2], B0[2][2], B1[2][2];
    const char* cA = (const char*)g.A + (size_t)cur.pm * tstep; const char* cB = (const char*)g.Bt + (size_t)cur.pn * tstep;
    S.a_ready(cur);
    PG8_STAGE(PG8_SB(0, 0), cB, voffB); PG8_STAGE(PG8_SA(0, 0), cA, voffA); PG8_STAGE(PG8_SB(0, 1), cB + hstep, voffB); PG8_STAGE(PG8_SA(0, 1), cA + hstep, voffA);
    if (wr == 1) PG8_BAR;
    PG8_WAIT_V(4); PG8_BAR;
    PG8_STAGE(PG8_SB(1, 0), cB + kstep, voffB); PG8_STAGE(PG8_SA(1, 0), cA + kstep, voffA); PG8_STAGE(PG8_SB(1, 1), cB + hstep + kstep, voffB);
    PG8_WAIT_V(6); PG8_BAR;
    PG8_STAMP();
    for (;;) {
        const bool has_next = S.next(ui + 1, nxt);
        const char* nA = has_next ? (const char*)g.A + (size_t)nxt.pm * tstep : cA; const char* nB = has_next ? (const char*)g.Bt + (size_t)nxt.pn * tstep : cB;
        for (int t = 0; t < nt; t += 2) {
            const bool last = (t == nt - 2);
            const char* a1 = cA + (size_t)(t + 1) * kstep;
            const char* a2 = last ? nA : cA + (size_t)(t + 2) * kstep; const char* b2 = last ? nB : cB + (size_t)(t + 2) * kstep;
            const char* a3 = a2 + kstep; const char* b3 = b2 + kstep;
            if (last && has_next) S.a_ready(nxt);
            PG8_LDB(B0, 0, 0); PG8_SCHED; PG8_LDA(At, 0, 0); PG8_STAGE(PG8_SA(1, 1), a1 + hstep, voffA);
            PG8_WAIT_L(8); PG8_BAR; PG8_WAIT_L(0); PG8_MMA(0, 0, At, B0); PG8_BAR; PG8_SCHED;
            PG8_LDB(B1, 0, 1); PG8_STAGE(PG8_SB(0, 0), b2, voffB);
            PG8_BAR; PG8_WAIT_L(0); PG8_MMA(0, 1, At, B1); PG8_BAR;
            PG8_LDA(At, 0, 1); PG8_STAGE(PG8_SA(0, 0), a2, voffA);
            PG8_BAR; PG8_WAIT_L(0); PG8_MMA(1, 0, At, B0); PG8_BAR; PG8_SCHED;
            PG8_STAGE(PG8_SB(0, 1), b2 + hstep, voffB);
            PG8_WAIT_V(6); PG8_BAR; PG8_MMA(1, 1, At, B1); PG8_BAR;
            PG8_LDB(B0, 1, 0); PG8_SCHED; PG8_LDA(At, 1, 0); PG8_STAGE(PG8_SA(0, 1), a2 + hstep, voffA);
            PG8_WAIT_L(8); PG8_BAR; PG8_WAIT_L(0); PG8_MMA(0, 0, At, B0); PG8_BAR; PG8_SCHED;
            PG8_LDB(B1, 1, 1); PG8_STAGE(PG8_SB(1, 0), b3, voffB);
            PG8_BAR; PG8_WAIT_L(0); PG8_MMA(0, 1, At, B1); PG8_BAR;
            PG8_LDA(At, 1, 1); PG8_STAGE(PG8_SA(1, 0), a3, voffA);
            PG8_BAR; PG8_WAIT_L(0); PG8_MMA(1, 0, At, B0); PG8_BAR; PG8_SCHED;
            PG8_STAGE(PG8_SB(1, 1), b3 + hstep, voffB);
            PG8_WAIT_V(6); PG8_BAR; PG8_MMA(1, 1, At, B1); PG8_BAR;
        }
        PG8_STAMP();
        if constexpr (!Epi::AFTER_DRAIN) { E(acc, cur, wr, wc, fr, fq); S.done(cur); }
        PG8_STAMP();
        if (!has_next) break;
#pragma unroll
        for (int a = 0; a < 2; ++a)
#pragma unroll
            for (int b = 0; b < 2; ++b)
#pragma unroll
                for (int m = 0; m < 4; ++m)
#pragma unroll
                    for (int n = 0; n < 2; ++n) acc[a][b][m][n] = (f32x4){0.f, 0.f, 0.f, 0.f};
        cur = nxt; cA = nA; cB = nB; ++ui;
    }
    PG8_WAIT_V(0);
    if (wr == 0) PG8_BAR;
    PG8_BAR;
    if constexpr (Epi::AFTER_DRAIN) { E.fused(acc, cur, wr, wc, fr, fq, lds, wid, lane); S.done(cur); }
    PG8_STAMP();
    if (STAMP && wid == 0) { stamps[lane] = lane < nts ? (((unsigned long long)(unsigned)ts_hi << 32) | (unsigned)ts_lo) : 0ull;
        if (lane == 62) stamps[62] = rt_entry; if (lane == 63) stamps[63] = (unsigned long long)wall_clock64(); }
#undef PG8_STAMP
#undef PG8_SA
#undef PG8_SB
#undef PG8_STAGE
#undef PG8_LDA
#undef PG8_LDB
#undef PG8_MMA
#undef PG8_WAIT_V
#undef PG8_WAIT_L
#undef PG8_BAR
#undef PG8_SCHED
}
}
using pg8::f32x4;
using pg8::Unit;
#define LAS __attribute__((address_space(3)))

#define XB_TMO      128
#define XB_XCNT(j)  (256  + 64 * (j))
#define XB_XSUB(j)  (1280 + 64 * (j))
#define XB_XGEN(j)  (2304 + 64 * (j))
#define XB_TOP      3328
#define XB_TOPGEN   3392
#define XCD_BAR_WORDS 3456
#define XB_SPIN_CAP (1u << 18)

__device__ __forceinline__ unsigned xb_ld(unsigned* p)              { return __hip_atomic_load(p, __ATOMIC_RELAXED, __HIP_MEMORY_SCOPE_AGENT); }
__device__ __forceinline__ unsigned xb_add(unsigned* p, unsigned v) { return __hip_atomic_fetch_add(p, v, __ATOMIC_RELAXED, __HIP_MEMORY_SCOPE_AGENT); }
__device__ __forceinline__ unsigned xb_xcc_id() { return (unsigned)__builtin_amdgcn_s_getreg((3 << 11) | 20) & 0xFu; }
#define XB_SPIN(cond, bar) do { unsigned _sp = 0; while (cond) { __builtin_amdgcn_s_sleep(1); \
    if ((++_sp & 255u) == 0u) { if (xb_ld(&(bar)[XB_TMO])) break; if (_sp > XB_SPIN_CAP) { atomicAdd(&(bar)[XB_TMO], 1u); break; } } } } while (0)

struct XcdBarrier {
    unsigned* bar; unsigned x;
    volatile LAS unsigned* st;
};

__device__ __forceinline__ XcdBarrier xcd_barrier_post(unsigned* bar, volatile LAS unsigned* st) {
    XcdBarrier b; b.bar = bar; b.x = xb_xcc_id(); b.st = st;
    if (threadIdx.x == 0) (void)xb_add(&bar[XB_XCNT(b.x)], 1u);
    return b;
}
__device__ __forceinline__ void xcd_barrier_complete(unsigned* bar, unsigned x, unsigned& nloc, unsigned& nx) {
    const unsigned G = gridDim.x * gridDim.y * gridDim.z;
    unsigned sum, cnt, mine, sp = 0u;
    for (;;) {
        sum = 0u; cnt = 0u; mine = 0u;
#pragma unroll
        for (unsigned j = 0; j < 16; ++j) { const unsigned c = xb_ld(&bar[XB_XCNT(j)]); sum += c; cnt += (c > 0u) ? 1u : 0u; mine = (j == x) ? c : mine; }
        if (sum == G) break;
        __builtin_amdgcn_s_sleep(1);
        if ((++sp & 255u) == 0u) { if (xb_ld(&bar[XB_TMO])) break; if (sp > XB_SPIN_CAP) { atomicAdd(&bar[XB_TMO], 1u); break; } }
    }
    nloc = mine > 0u ? mine : 1u; nx = cnt > 0u ? cnt : 1u;
}

__device__ __forceinline__ void xcd_barrier(const XcdBarrier& b, const bool leader_thread) {
    asm volatile("s_waitcnt vmcnt(0)" ::: "memory");
    __syncthreads();
    if (leader_thread) {
        unsigned* bar = b.bar;
        __builtin_amdgcn_s_waitcnt(0);
        unsigned nloc = b.st[0], nx = b.st[1];
        if (nloc == 0u) { xcd_barrier_complete(bar, b.x, nloc, nx); b.st[0] = nloc; b.st[1] = nx; }
        const unsigned old = xb_add(&bar[XB_XSUB(b.x)], 1u);
        const unsigned gen = old / nloc;
        if (old + 1u == (gen + 1u) * nloc) {
            __builtin_amdgcn_fence(__ATOMIC_RELEASE, "agent");
            asm volatile("s_waitcnt vmcnt(0)" ::: "memory");
            const unsigned og = xb_add(&bar[XB_TOP], 1u);
            const unsigned tg = og / nx;
            if (og + 1u == (tg + 1u) * nx) xb_add(&bar[XB_TOPGEN], 1u);
            else XB_SPIN(xb_ld(&bar[XB_TOPGEN]) == tg, bar);
            __builtin_amdgcn_fence(__ATOMIC_ACQUIRE, "agent");
            xb_add(&bar[XB_XGEN(b.x)], 1u);
            asm volatile("s_waitcnt vmcnt(0)" ::: "memory");
        } else {
            XB_SPIN(xb_ld(&bar[XB_XGEN(b.x)]) == gen, bar);
            __builtin_amdgcn_fence(__ATOMIC_ACQUIRE, "agent");
            asm volatile("s_waitcnt vmcnt(0)" ::: "memory");
        }
    }
    __syncthreads();
}


constexpr int LDS_BYTES = 147456;
constexpr int MISC_OFF = 147456 - 256;

DI void p0_mod(const int wv, KP p, int item, char* smem) {
    const int l = item / 96, cb = item % 96;
    const int tid = opaque_tid(wv);
    float* s_l = (float*)smem;
    float* red = s_l + 9 * 1024;
    __syncthreads();
    for (int i = tid; i < 9 * 1024; i += 512) {
        int bb = i >> 10, k = i & 1023;
        float v = bb < 8 ? p->c[bb * 1024 + k] : p->c_ctx[k];
        s_l[i] = v / (1.f + expf(-v));
    }
    __syncthreads();
    const int col = cb * 64 + (tid & 63), kg = tid >> 6;
    float acc[9];
#pragma unroll
    for (int bb = 0; bb < 9; ++bb) acc[bb] = 0.f;
    const float* wp = p->w_mod + (size_t)l * 1024 * 6144 + col;
#pragma unroll 8
    for (int k = kg * 128; k < kg * 128 + 128; ++k) {
        float wv_ = wp[(size_t)k * 6144];
#pragma unroll
        for (int bb = 0; bb < 9; ++bb) acc[bb] += s_l[bb * 1024 + k] * wv_;
    }
#pragma unroll
    for (int bb = 0; bb < 9; ++bb) red[(kg * 9 + bb) * 64 + (tid & 63)] = acc[bb];
    __syncthreads();
    for (int i = tid; i < 9 * 64; i += 512) {
        int bb = i >> 6, cc = i & 63;
        int cg_ = cb * 64 + cc;
        float v = 0.f;
#pragma unroll
        for (int q = 0; q < 8; ++q) v += red[(q * 9 + bb) * 64 + cc];
        v += p->b_mod[l * 6144 + cg_];
        int sec = cg_ >> 10, k = cg_ & 1023;
        if (sec == 1) v = p->norm_gain[(l * 2 + 0) * 1024 + k] * (1.f + v);
        if (sec == 4) v = p->norm_gain[(l * 2 + 1) * 1024 + k] * (1.f + v);
        WS{p->ws}.modv()[((size_t)(l * 6 + sec) * 9 + bb) * 1024 + k] = v;
    }
}

DI void p0_convert(const int wv, KP p, int mode, int l, int kt, int nt, char* smem) {
    float* tile = (float*)smem;
    const int tid = opaque_tid(wv);
    const float* src;
    unsigned short* dst;
    int srcN, K;
    if (mode == 0) { src = p->w_in + (size_t)l * 1024 * INC; srcN = INC; K = 1024; dst = WS{p->ws}.WtIn() + (size_t)l * NP * 1024; }
    else if (mode == 1) { src = p->w_out + (size_t)l * 1024 * 1024; srcN = 1024; K = 1024; dst = WS{p->ws}.WtOut() + (size_t)l * 1024 * 1024; }
    else if (mode == 2) { src = p->w_ffn_in + (size_t)l * 1024 * FFN2; srcN = FFN2; K = 1024; dst = WS{p->ws}.WtF1() + (size_t)l * FFN2 * 1024; }
    else { src = p->w_ffn_out + (size_t)l * FFN * 1024; srcN = 1024; K = FFN; dst = WS{p->ws}.WtF2() + (size_t)l * 1024 * FFN; }
    __syncthreads();
    {
        const int c4 = (tid & 15) * 4;
        const int n = nt * 64 + c4;
        int sc;
        if (mode == 0) {
            int nn = n;
            if (n >= C_AQ && n < C_AV) { const int q = n & 31; nn = (n & ~31) + 16 * ((q >> 2) & 1) + 4 * (q >> 3) + (q & 3); }
            sc = nn < 1024 ? nn : (nn < 2304 ? nn + 16 : (nn < 2320 ? nn - 1280 : -1));
        }
        else if (mode == 2) { int pn_ = n >> 8, wi = n & 255; sc = pn_ * 128 + (wi & 127) + (wi >= 128 ? FFN : 0); }
        else sc = n;
#pragma unroll
        for (int i = 0; i < 2; ++i) {
            const int kk = (tid >> 4) + 32 * i;
            float4 v = make_float4(0.f, 0.f, 0.f, 0.f);
            if (sc >= 0) v = *(const float4*)(src + (size_t)(kt * 64 + kk) * srcN + sc);
            tile[kk * 65 + c4 + 0] = v.x; tile[kk * 65 + c4 + 1] = v.y; tile[kk * 65 + c4 + 2] = v.z; tile[kk * 65 + c4 + 3] = v.w;
        }
    }
    __syncthreads();
    {
        const int n = tid >> 3, k0 = (tid & 7) * 8;
        unsigned o[4];
#pragma unroll
        for (int q = 0; q < 4; ++q) o[q] = cvtpk(tile[(k0 + 2 * q) * 65 + n], tile[(k0 + 2 * q + 1) * 65 + n]);
        unsigned short* d = dst + (size_t)(nt * 64 + n) * K + kt * 64 + k0;
        *(uint4*)d = make_uint4(o[0], o[1], o[2], o[3]);
    }
}

DI void p0_fold(const int wv, KP p, int l, int kt, int nt, char* smem) {
    float* pwS = (float*)smem;
    float* woS = pwS + 64 * 65;
    const int tid = opaque_tid(wv), n = tid & 63, kg = tid >> 6;
    float acc[8];
#pragma unroll
    for (int i = 0; i < 8; ++i) acc[i] = 0.f;
    for (int jc = 0; jc < 4; ++jc) {
        __syncthreads();
        for (int i = tid; i < 64 * 64; i += 512) {
            int r = i >> 6, cc = i & 63;
            pwS[r * 65 + cc] = p->pw_w[(size_t)l * 65536 + (kt * 64 + r) * 256 + jc * 64 + cc];
            woS[r * 64 + cc] = p->w_out[(size_t)l * 1024 * 1024 + (size_t)(768 + jc * 64 + r) * 1024 + nt * 64 + cc];
        }
        __syncthreads();
        for (int j = 0; j < 64; ++j) {
            float wo = woS[j * 64 + n];
#pragma unroll
            for (int i = 0; i < 8; ++i) acc[i] += pwS[(kg * 8 + i) * 65 + j] * wo;
        }
    }
    unsigned o[4];
#pragma unroll
    for (int q = 0; q < 4; ++q) o[q] = cvtpk(acc[2 * q], acc[2 * q + 1]);
    unsigned short* d = WS{p->ws}.WtOut() + (size_t)l * 1024 * 1024 + (size_t)(nt * 64 + n) * 1024 + 768 + kt * 64 + kg * 8;
    *(uint4*)d = make_uint4(o[0], o[1], o[2], o[3]);
}

DI void p0_shw(const int wv, KP p, const int l, const bool second, const int nb, char* smem) {
    float* shs = (float*)smem;
    const int tid = opaque_tid(wv), lane = tid & 63, w = tid >> 6;
    const float* shsrc = WS{p->ws}.modv() + (size_t)((l * 6 + (second ? 3 : 0)) * 9) * 1024;
    const unsigned short* Wt = second ? WS{p->ws}.WtF1() + (size_t)l * FFN2 * 1024 : WS{p->ws}.WtIn() + (size_t)l * NP * 1024;
    float* dst = second ? WS{p->ws}.shW2() + (size_t)l * 9 * FFN2 : WS{p->ws}.shW1() + (size_t)l * 9 * NP;
    const int NN = second ? FFN2 : NP;
    __syncthreads();
    for (int i = tid; i < 9 * 1024; i += 512) shs[i] = shsrc[i];
    __syncthreads();
    for (int q = 0; q < 8; ++q) {
        const int n = nb * 64 + w * 8 + q;
        const unsigned short* wr = Wt + (size_t)n * 1024 + lane * 16;
        uint4 a = *(const uint4*)wr, b = *(const uint4*)(wr + 8);
        float wv_[16];
        wv_[0] = bflo(a.x); wv_[1] = bfhi(a.x); wv_[2] = bflo(a.y); wv_[3] = bfhi(a.y);
        wv_[4] = bflo(a.z); wv_[5] = bfhi(a.z); wv_[6] = bflo(a.w); wv_[7] = bfhi(a.w);
        wv_[8] = bflo(b.x); wv_[9] = bfhi(b.x); wv_[10] = bflo(b.y); wv_[11] = bfhi(b.y);
        wv_[12] = bflo(b.z); wv_[13] = bfhi(b.z); wv_[14] = bflo(b.w); wv_[15] = bfhi(b.w);
#pragma unroll
        for (int bb = 0; bb < 9; ++bb) {
            float s = 0.f;
#pragma unroll
            for (int e = 0; e < 16; ++e) s += wv_[e] * shs[bb * 1024 + lane * 16 + e];
#pragma unroll
            for (int o = 32; o >= 1; o >>= 1) s += SX(s, o);
            if (lane == 0) dst[(size_t)bb * NN + n] = s;
        }
    }
}

DI void prep_item(const int wv, KP p, const int kind, const int l, const int idx, char* smem) {
    if (kind == 0) p0_convert(wv, p, 0, l, idx / 40, idx % 40, smem);
    else if (kind == 1) p0_convert(wv, p, 1, l, idx / 16, idx % 16, smem);
    else if (kind == 2) p0_convert(wv, p, 2, l, idx / 88, idx % 88, smem);
    else if (kind == 3) p0_convert(wv, p, 3, l, idx / 16, idx % 16, smem);
    else if (kind == 4) p0_fold(wv, p, l, idx / 16, idx % 16, smem);
    else p0_shw(wv, p, l, kind == 6, idx, smem);
}
constexpr int N_K0 = 16 * 40, N_K1 = 12 * 16, N_K2 = 16 * 88, N_K3 = 44 * 16, N_K4 = 64, N_K5 = 40, N_K6 = 88;

DI void fill_tail(const int wv, KP p, const int list, const int nbusy, char* smem) {
    const int nb_ = (int)gridDim.x > nbusy + 32 ? nbusy : 0;
    const int c = (int)blockIdx.x - nb_;
    if (c < 0) return;
    const int stride = (int)gridDim.x - nb_;
    int total;
    if (list == 0) total = N_K1 + N_K4 + N_K2;
    else if (list == 1) total = N_K3 + N_K0 + N_K1 + N_K4 + N_K6;
    else if (list == 2) total = N_K2 + N_K3 + N_K5;
    else total = N_K6;
    for (int it = c; it < total; it += stride) {
        int i = it;
        if (list == 0) {
            if (i < N_K1) { prep_item(wv, p, 1, 0, i, smem); continue; }
            i -= N_K1;
            if (i < N_K4) { prep_item(wv, p, 4, 0, i, smem); continue; }
            i -= N_K4;
            prep_item(wv, p, 2, 0, i, smem);
        } else if (list == 1) {
            if (i < N_K3) { prep_item(wv, p, 3, 0, i, smem); continue; }
            i -= N_K3;
            if (i < N_K0) { prep_item(wv, p, 0, 1, i, smem); continue; }
            i -= N_K0;
            if (i < N_K1) { prep_item(wv, p, 1, 1, i, smem); continue; }
            i -= N_K1;
            if (i < N_K4) { prep_item(wv, p, 4, 1, i, smem); continue; }
            i -= N_K4;
            prep_item(wv, p, 6, 0, i, smem);
        } else if (list == 2) {
            if (i < N_K2) { prep_item(wv, p, 2, 1, i, smem); continue; }
            i -= N_K2;
            if (i < N_K3) { prep_item(wv, p, 3, 1, i, smem); continue; }
            i -= N_K3;
            prep_item(wv, p, 5, 1, i, smem);
        } else {
            prep_item(wv, p, 6, 1, i, smem);
        }
    }
    __syncthreads();
}

DI void phase0a(const int wv, KP p, char* smem) {
    const int N_MOD = 192;
    const int total = N_MOD + N_K0 + 1;
    for (int it = blockIdx.x; it < total; it += gridDim.x) {
        int i = it;
        if (i < N_MOD) { p0_mod(wv, p, i, smem); continue; }
        i -= N_MOD;
        if (i < N_K0) { prep_item(wv, p, 0, 0, i, smem); continue; }
        const int tid_m = opaque_tid(wv);
        for (int e = tid_m; e < 128 * 16; e += 512) {
            int pos = e >> 4, f = e & 15;
            float freq = powf(10000.f, -(float)f / 16.f);
            float ang = (float)pos * freq;
            WS{p->ws}.rope()[e * 2 + 0] = cosf(ang);
            WS{p->ws}.rope()[e * 2 + 1] = sinf(ang);
        }
    }
}

DI void phase0c(const int wv, KP p, char* smem) {
    const int tid = opaque_tid(wv), lane = tid & 63, w = tid >> 6;
    for (int it = blockIdx.x; it < N_K5; it += gridDim.x) p0_shw(wv, p, 0, false, it, smem);
    float* rq = WS{p->ws}.rowsq();
    for (int rb = blockIdx.x; rb < NTOK / 8; rb += gridDim.x) {
        const int r = rb * 8 + w;
        const int bb = r < NLAT ? (r >> 13) : 8;
        const float* xp = r < NLAT ? p->x + (size_t)r * 1024 : p->ctx + (size_t)(r - NLAT) * 1024;
        const float* Gv = WS{p->ws}.modv() + (size_t)((0 * 6 + 1) * 9 + bb) * 1024;
        float s = 0.f;
#pragma unroll
        for (int i = 0; i < 4; ++i) {
            const float4 v = *(const float4*)(xp + i * 256 + lane * 4);
            const float4 gq = *(const float4*)(Gv + i * 256 + lane * 4);
            s += v.x * v.x + v.y * v.y + v.z * v.z + v.w * v.w;
            uint2 o;
            o.x = cvtpk(v.x * gq.x, v.y * gq.y);
            o.y = cvtpk(v.z * gq.z, v.w * gq.w);
            *(uint2*)(WS{p->ws}.xg() + (size_t)r * 1024 + i * 256 + lane * 4) = o;
        }
#pragma unroll
        for (int o = 32; o >= 1; o >>= 1) s += SX(s, o);
        if (lane == 0) rq[r] = s;
    }
}

struct EpiInproj {
    static constexpr bool PERM = true, AFTER_DRAIN = false;
    char* ws; int l;
    DI void operator()(const f32x4 (&acc)[2][2][4][2], const Unit& u, int wr, int wc, int fr, int fq) const {
        asm volatile("" : "+v"(fr), "+v"(fq));
        asm volatile("" : "+s"(wr), "+s"(wc));
        const WS W{ws};
        const int pn = u.pn, r0 = u.pm * 256;
        const int bb = r0 < NLAT ? (r0 >> 13) : 8;
        const float* sh = W.shW1() + (size_t)(l * 9 + bb) * NP;
        const float* rq = W.rowsq() + (size_t)(l * 2) * NTOK + r0 + 64 * wr + fr;
        unsigned short* P = W.P();
        float rs[2][4];
#pragma unroll
        for (int ai = 0; ai < 2; ++ai)
#pragma unroll
            for (int m = 0; m < 4; ++m) rs[ai][m] = rq[128 * ai + 16 * m];
#pragma unroll
        for (int bj = 0; bj < 2; ++bj) {
            const int cb = 256 * pn + 128 * bj + 32 * wc + 8 * fq;
            const float4 s0 = *(const float4*)(sh + cb);
            const float4 s1 = *(const float4*)(sh + cb + 4);
            const bool is_aq = (pn == 4 || pn == 5), is_ak = (pn == 6 && bj == 0), is_av = (pn == 6 && bj == 1);
#pragma unroll
            for (int ai = 0; ai < 2; ++ai)
#pragma unroll
                for (int m = 0; m < 4; ++m) {
                    const int r = r0 + 128 * ai + 64 * wr + 16 * m + fr;
                    const float rstd = rsqrtf(rs[ai][m] * (1.f / 1024.f) + EPS);
                    float v0[4], v1[4];
                    v0[0] = rstd * acc[ai][bj][m][0][0] + s0.x; v0[1] = rstd * acc[ai][bj][m][0][1] + s0.y;
                    v0[2] = rstd * acc[ai][bj][m][0][2] + s0.z; v0[3] = rstd * acc[ai][bj][m][0][3] + s0.w;
                    v1[0] = rstd * acc[ai][bj][m][1][0] + s1.x; v1[1] = rstd * acc[ai][bj][m][1][1] + s1.y;
                    v1[2] = rstd * acc[ai][bj][m][1][2] + s1.z; v1[3] = rstd * acc[ai][bj][m][1][3] + s1.w;
                    if (pn == 9) {
                        if (bj == 0 && wc == 0 && fq < 2) {
                            *(float4*)(W.gates() + (size_t)r * 16 + 8 * fq) = make_float4(v0[0], v0[1], v0[2], v0[3]);
                            *(float4*)(W.gates() + (size_t)r * 16 + 8 * fq + 4) = make_float4(v1[0], v1[1], v1[2], v1[3]);
                        }
                        continue;
                    }
                    if (is_aq || is_ak) {
                        if (r < NLAT) {
                            const int t = r & (SEQ - 1);
                            const int pos = ((wc & 1) == 0) ? (t >> 6) : (t & 63);
                            const float4 cs0 = *(const float4*)(W.rope() + (size_t)(pos * 16 + 4 * fq) * 2);
                            const float4 cs1 = *(const float4*)(W.rope() + (size_t)(pos * 16 + 4 * fq) * 2 + 4);
                            const float cc[4] = {cs0.x, cs0.z, cs1.x, cs1.z};
                            const float sn[4] = {cs0.y, cs0.w, cs1.y, cs1.w};
#pragma unroll
                            for (int i = 0; i < 4; ++i) {
                                const float x1 = v0[i], x2 = v1[i];
                                v0[i] = x1 * cc[i] - x2 * sn[i];
                                v1[i] = x2 * cc[i] + x1 * sn[i];
                            }
                        }
                        if (is_aq) {
#pragma unroll
                            for (int i = 0; i < 4; ++i) { v0[i] *= 0.125f * 1.44269504089f; v1[i] *= 0.125f * 1.44269504089f; }
                        }
                        const int c32 = 256 * pn + 128 * bj + 32 * wc;
                        uint2 o;
                        o.x = cvtpk(v0[0], v0[1]); o.y = cvtpk(v0[2], v0[3]);
                        *(uint2*)(P + (size_t)r * PSTR + c32 + 4 * fq) = o;
                        o.x = cvtpk(v1[0], v1[1]); o.y = cvtpk(v1[2], v1[3]);
                        *(uint2*)(P + (size_t)r * PSTR + c32 + 16 + 4 * fq) = o;
                        continue;
                    }
                    if (pn == 1) {
#pragma unroll
                        for (int i = 0; i < 4; ++i) { v0[i] *= 0.125f; v1[i] *= 0.125f; }
                    }
                    if (!(pn == 2 || is_av))
                        *(uint4*)(P + (size_t)r * PSTR + cb) = make_uint4(cvtpk(v0[0], v0[1]), cvtpk(v0[2], v0[3]), cvtpk(v1[0], v1[1]), cvtpk(v1[2], v1[3]));
                    if (pn == 1 || pn == 2 || is_av) {
                        unsigned short* T = pn == 1 ? W.MKT() : (pn == 2 ? W.MVT() : W.AVT());
                        const int nb2 = cb - (pn == 1 ? C_MK : (pn == 2 ? C_MV : C_AV));
#pragma unroll
                        for (int i = 0; i < 4; ++i) {
                            T[(size_t)(nb2 + i) * NTOK + r] = (unsigned short)(cvtpk(v0[i], 0.f) & 0xffffu);
                            T[(size_t)(nb2 + 4 + i) * NTOK + r] = (unsigned short)(cvtpk(v1[i], 0.f) & 0xffffu);
                        }
                    }
                }
        }
    }
};

struct EpiResid {
    static constexpr bool PERM = false, AFTER_DRAIN = true;
    const float* xold_lat; const float* xold_ctx; float* xnew_lat; float* xnew_ctx;
    const float* gate;
    const float* Gnext;
    unsigned short* xg;
    float* rsq;
    DI void operator()(const f32x4 (&acc)[2][2][4][2], const Unit& u, int wr, int wc, int fr, int fq) const {}
    DI void fused(f32x4 (&acc)[2][2][4][2], const Unit& u, int wr, int wc, int fr, int fq, LAS unsigned char* lds, int wid, int lane) const {
        asm volatile("" : "+v"(fr), "+v"(fq), "+v"(lane));
        asm volatile("" : "+s"(wr), "+s"(wc), "+s"(wid));
        const int pn = u.pn, r0 = u.pm * 256;
        const int bb = r0 < NLAT ? (r0 >> 13) : 8;
        const float* xo_b = r0 < NLAT ? xold_lat + (size_t)r0 * 1024 : xold_ctx + (size_t)(r0 - NLAT) * 1024;
        float* xn_b = r0 < NLAT ? xnew_lat + (size_t)r0 * 1024 : xnew_ctx + (size_t)(r0 - NLAT) * 1024;
        const int c = 256 * pn + 4 * lane;
        const float4 g4 = *(const float4*)(gate + (size_t)bb * 1024 + c);
        float4 q4 = make_float4(0.f, 0.f, 0.f, 0.f);
        if (Gnext) q4 = *(const float4*)(Gnext + (size_t)bb * 1024 + c);
#pragma unroll
        for (int ai = 0; ai < 2; ++ai) {
            float4 xo[16];
#pragma unroll
            for (int rr = 0; rr < 8; ++rr) xo[rr] = *(const float4*)(xo_b + (size_t)(128 * ai + wid * 16 + rr) * 1024 + c);
            __builtin_amdgcn_sched_barrier(0);
#pragma unroll
            for (int m = 0; m < 4; ++m)
#pragma unroll
                for (int bj = 0; bj < 2; ++bj)
#pragma unroll
                    for (int n = 0; n < 2; ++n) {
                        const int row = 64 * wr + 16 * m + fr;
                        const int ch = 32 * bj + 8 * wc + 4 * n + fq;
                        *(LAS f32x4*)(lds + row * 1024 + ((ch ^ (row & 15)) << 4)) = acc[ai][bj][m][n];
                    }
            LDS_BARRIER();
#pragma unroll
            for (int rr = 8; rr < 16; ++rr) xo[rr] = *(const float4*)(xo_b + (size_t)(128 * ai + wid * 16 + rr) * 1024 + c);
            __builtin_amdgcn_sched_barrier(0);
            float s[16];
#pragma unroll
            for (int rr = 0; rr < 16; ++rr) {
                if (rr == 8) __builtin_amdgcn_sched_barrier(0);
                const int row = wid * 16 + rr;
                const f32x4 a4 = *(const LAS f32x4*)(lds + row * 1024 + ((lane ^ (row & 15)) << 4));
                const int rl = 128 * ai + row;
                float4 o;
                o.x = xo[rr].x + g4.x * a4[0];
                o.y = xo[rr].y + g4.y * a4[1];
                o.z = xo[rr].z + g4.z * a4[2];
                o.w = xo[rr].w + g4.w * a4[3];
                *(float4*)(xn_b + (size_t)rl * 1024 + c) = o;
                if (Gnext) {
                    uint2 pk;
                    pk.x = cvtpk(o.x * q4.x, o.y * q4.y);
                    pk.y = cvtpk(o.z * q4.z, o.w * q4.w);
                    *(uint2*)(xg + (size_t)(r0 + rl) * 1024 + c) = pk;
                }
                s[rr] = o.x * o.x + o.y * o.y + o.z * o.z + o.w * o.w;
            }
            if (rsq) {
                const bool b5 = lane & 32, b4 = lane & 16, b3 = lane & 8, b2 = lane & 4;
                float t[8], u2[4], v2[2];
#pragma unroll
                for (int j = 0; j < 8; ++j) { const float snd = b5 ? s[j] : s[j + 8]; const float kp = b5 ? s[j + 8] : s[j]; t[j] = kp + SX(snd, 32); }
#pragma unroll
                for (int j = 0; j < 4; ++j) { const float snd = b4 ? t[j] : t[j + 4]; const float kp = b4 ? t[j + 4] : t[j]; u2[j] = kp + SX(snd, 16); }
#pragma unroll
                for (int j = 0; j < 2; ++j) { const float snd = b3 ? u2[j] : u2[j + 2]; const float kp = b3 ? u2[j + 2] : u2[j]; v2[j] = kp + SX(snd, 8); }
                float tot;
                { const float snd = b2 ? v2[0] : v2[1]; const float kp = b2 ? v2[1] : v2[0]; tot = kp + SX(snd, 4); }
                tot += SX(tot, 2);
                tot += SX(tot, 1);
                const int rrow = (b5 ? 8 : 0) + (b4 ? 4 : 0) + (b3 ? 2 : 0) + (b2 ? 1 : 0);
                if ((lane & 3) == 0) atomicAdd(rsq + r0 + 128 * ai + wid * 16 + rrow, tot);
            }
            LDS_BARRIER();
        }
    }
};

struct EpiFfnin {
    static constexpr bool PERM = true, AFTER_DRAIN = false;
    char* ws; int l;
    DI void operator()(const f32x4 (&acc)[2][2][4][2], const Unit& u, int wr, int wc, int fr, int fq) const {
        asm volatile("" : "+v"(fr), "+v"(fq));
        asm volatile("" : "+s"(wr), "+s"(wc));
        const WS W{ws};
        const int pn = u.pn, r0 = u.pm * 256;
        const int bb = r0 < NLAT ? (r0 >> 13) : 8;
        const float* sh = W.shW2() + (size_t)(l * 9 + bb) * FFN2 + 256 * pn + 32 * wc + 8 * fq;
        const float* rq = W.rowsq() + (size_t)(l * 2 + 1) * NTOK + r0 + 64 * wr + fr;
        unsigned short* hid = W.hid() + (size_t)(r0 + 64 * wr + fr) * FFN + 128 * pn + 32 * wc + 8 * fq;
        float rs[2][4];
#pragma unroll
        for (int ai = 0; ai < 2; ++ai)
#pragma unroll
            for (int m = 0; m < 4; ++m) rs[ai][m] = rq[128 * ai + 16 * m];
        const float4 sg0 = *(const float4*)(sh), sg1 = *(const float4*)(sh + 4);
        const float4 su0 = *(const float4*)(sh + 128), su1 = *(const float4*)(sh + 132);
        const float sg[8] = {sg0.x, sg0.y, sg0.z, sg0.w, sg1.x, sg1.y, sg1.z, sg1.w};
        const float su[8] = {su0.x, su0.y, su0.z, su0.w, su1.x, su1.y, su1.z, su1.w};
#pragma unroll
        for (int ai = 0; ai < 2; ++ai)
#pragma unroll
            for (int m = 0; m < 4; ++m) {
                const float rstd = rsqrtf(rs[ai][m] * (1.f / 1024.f) + EPS);
                float h[8];
#pragma unroll
                for (int n = 0; n < 2; ++n)
#pragma unroll
                    for (int i = 0; i < 4; ++i) {
                        const float gg = rstd * acc[ai][0][m][n][i] + sg[4 * n + i];
                        const float uu = rstd * acc[ai][1][m][n][i] + su[4 * n + i];
                        h[4 * n + i] = silu_f(gg) * uu;
                    }
                *(uint4*)(hid + (size_t)(128 * ai + 16 * m) * FFN) = make_uint4(cvtpk(h[0], h[1]), cvtpk(h[2], h[3]), cvtpk(h[4], h[5]), cvtpk(h[6], h[7]));
            }
    }
};

struct OneUnit {
    Unit u;
    DI bool next(int i, Unit& o) const { if (i != 0) return false; o = u; return true; }
    DI void a_ready(const Unit&) const {}
    DI void done(const Unit&) const {}
};
template <class Epi>
DI void run_gemm(char* smem, const unsigned short* A, const unsigned short* Bt, int M, int N, int K, const Epi& E) {
    pg8::Gemm g;
    g.A = A; g.Bt = Bt; g.M = M; g.N = N; g.K = K;
    pg8::StaticOrder S;
    S.init(M, N, (int)gridDim.x, (int)blockIdx.x);
    __syncthreads();
    if constexpr (Epi::AFTER_DRAIN) {
        for (int i = 0;; ++i) {
            OneUnit O;
            if (!S.next(i, O.u)) break;
            pg8::gemm_phase<Epi, OneUnit, false>((LAS unsigned char*)smem, g, O, E, nullptr);
            LDS_BARRIER();
        }
    } else {
        pg8::gemm_phase<Epi, pg8::StaticOrder, false>((LAS unsigned char*)smem, g, S, E, nullptr);
    }
    __syncthreads();
}

DI float scan_sum(float v, int lane, int dir) {
#pragma unroll
    for (int d = 1; d < 64; d <<= 1) {
        float o = shfl_i(v, dir ? lane + d : lane - d);
        bool ok = dir ? (lane + d < 64) : (lane >= d);
        if (ok) v += o;
    }
    return v;
}
DI float scan_max(float v, int lane, int dir) {
#pragma unroll
    for (int d = 1; d < 64; d <<= 1) {
        float o = shfl_i(v, dir ? lane + d : lane - d);
        bool ok = dir ? (lane + d < 64) : (lane >= d);
        if (ok) v = fmaxf(v, o);
    }
    return v;
}


DI void mlstm_chain(const int wv, KP p, const int l_, const int chain, char* smem) {
    const int l = opaque_s(l_);
    const int tid = opaque_tid(wv), lane = tid & 63, w = tid >> 6, g = lane >> 5, lr = lane & 31;
    const int w4 = w & 3;
    const int tb = w4 >> 1, eb = w4 & 1;
    const bool roleA = w < 4;
    const int dir = chain & 1, head = (chain >> 1) & 3, b = chain >> 3;
    char* T = smem;
    char* Cs = smem + 65536;
    float* n_s = (float*)(smem + 81920);
    float* wgw = (float*)(smem + 82432) + w4 * 64;
    float* sc_a = (float*)(smem + 83968);
    float* sc_pm = sc_a + 8 * 64;
    float* sc_bc = sc_pm + 8 * 64;
    float* sc_be = sc_bc + 8 * 64;
    float* sc_pa = sc_be + 8;
    const int lrow = tid >> 3, lch = tid & 7;
    const WS W{p->ws};
    const float bias_i = p->gate_bias[l * 16 + dir * 8 + head];
    const float bias_f = p->gate_bias[l * 16 + dir * 8 + 4 + head];
#define CHAIN_ROWBASE(step_) ((step_) < 4 ? (NLAT + b * CTXL + (dir ? 3 - (step_) : (step_)) * 64) : (b * SEQ + (dir ? 127 - ((step_) - 4) : (step_) - 4) * 64))
#define CHAIN_PREFETCHA(step_)                                                                              \
    {                                                                                                      \
        const int pr0 = CHAIN_ROWBASE(step_);                                                              \
        const unsigned short* pq = W.P() + (size_t)(pr0 + lrow) * PSTR + head * 64 + lch * 8;              \
        rqA = *(const uint4*)(pq + C_MQ);                                                                  \
        rkA = *(const uint4*)(pq + C_MK);                                                                  \
        const size_t to = (size_t)(head * 64 + lrow) * NTOK + pr0 + lch * 8;                               \
        rktA = *(const uint4*)(W.MKT() + to);                                                              \
        rvtA = *(const uint4*)(W.MVT() + to);                                                              \
    }
#define CHAIN_PREFETCHB(step_)                                                                              \
    {                                                                                                      \
        const int pr0 = CHAIN_ROWBASE(step_);                                                              \
        const unsigned short* pq = W.P() + (size_t)(pr0 + lrow) * PSTR + head * 64 + lch * 8;              \
        rqB = *(const uint4*)(pq + C_MQ);                                                                  \
        rkB = *(const uint4*)(pq + C_MK);                                                                  \
        const size_t to = (size_t)(head * 64 + lrow) * NTOK + pr0 + lch * 8;                               \
        rktB = *(const uint4*)(W.MKT() + to);                                                              \
        rvtB = *(const uint4*)(W.MVT() + to);                                                              \
    }
#define CHAIN_TILE_STOREA(buf_)                                                                             \
    {                                                                                                      \
        char* tb_ = T + (buf_) * 32768 + lds_off(lrow, lch);                                               \
        *(uint4*)(tb_) = rqA;                                                                              \
        *(uint4*)(tb_ + 8192) = rkA;                                                                       \
        *(uint4*)(tb_ + 16384) = rktA;                                                                     \
        *(uint4*)(tb_ + 24576) = rvtA;                                                                     \
    }
#define CHAIN_TILE_STOREB(buf_)                                                                             \
    {                                                                                                      \
        char* tb_ = T + (buf_) * 32768 + lds_off(lrow, lch);                                               \
        *(uint4*)(tb_) = rqB;                                                                              \
        *(uint4*)(tb_ + 8192) = rkB;                                                                       \
        *(uint4*)(tb_ + 16384) = rktB;                                                                     \
        *(uint4*)(tb_ + 24576) = rvtB;                                                                     \
    }
#define CHAIN_GLOAD(c_)                                                                                    \
    {                                                                                                      \
        const int pr0 = CHAIN_ROWBASE(c_);                                                                 \
        g_i = W.gates()[(size_t)(pr0 + lane) * 16 + dir * 8 + head];                                       \
        g_f = W.gates()[(size_t)(pr0 + lane) * 16 + dir * 8 + 4 + head];                                   \
    }
#define CHAIN_SCAN(c_)                                                                                     \
    {                                                                                                      \
        const int sl = (c_) & 7;                                                                           \
        const float li = g_i + bias_i;                                                                     \
        const float xfg = g_f + bias_f;                                                                    \
        const float lf = fminf(xfg, 0.f) - log1pf(expf(-fabsf(xfg)));                                      \
        const float bc = scan_sum(lf, lane, dir);                                                          \
        const float a = li - bc;                                                                           \
        const float pm = scan_max(a, lane, dir);                                                           \
        sc_a[sl * 64 + lane] = a;                                                                          \
        sc_pm[sl * 64 + lane] = pm;                                                                        \
        sc_bc[sl * 64 + lane] = bc;                                                                        \
        if (lane == (dir ? 0 : 63)) { sc_be[sl] = bc; sc_pa[sl] = pm; }                                    \
    }
    float g_i = 0.f, g_f = 0.f;
    if (roleA) __builtin_amdgcn_s_setprio(3);
    uint4 rqA, rkA, rktA, rvtA, rqB, rkB, rktB, rvtB;
    __syncthreads();
    { unsigned z0 = 0u; asm volatile("" : "+v"(z0)); *(uint4*)(Cs + tid * 16) = make_uint4(z0, z0, z0, z0); }
    if (tid < 128) n_s[tid] = 0.f;
    CHAIN_PREFETCHB(0);
    if (!roleA) {
        CHAIN_GLOAD(w4);
        CHAIN_SCAN(w4);
        CHAIN_GLOAD(4 + w4);
    }
    CHAIN_TILE_STOREB(0);
    CHAIN_PREFETCHA(1);
    CHAIN_PREFETCHB(2);
    f32x16 CT;
#pragma unroll
    for (int r = 0; r < 16; ++r) CT[r] = 0.f;
    float m = 0.f;
    __syncthreads();
    for (int step0 = 0; step0 < 132; step0 += 2) {
        {
            const int step = step0;
        const int cur = step & 1, nxt = cur ^ 1;
        const int j = step & 7;
        const int r0 = CHAIN_ROWBASE(step);
        if (step + 1 < 132) CHAIN_TILE_STOREA(nxt);
        if (step + 3 < 132) CHAIN_PREFETCHA(step + 3);
        const char* Qs = T + cur * 32768;
        const char* Ks = Qs + 8192;
        const char* KTs = Qs + 16384;
        const char* VTs = Qs + 24576;
        const float* a_s = sc_a + j * 64;
        const float b_end = sc_be[j];
        const float pmall = sc_pa[j];
        const float M = fmaxf(m, pmall);
        const float decay = __expf(m - M);
        const float m_new = b_end + M;
        const int tl = tb * 32 + lr;
        if (roleA) {
            const float mm_t = fmaxf(m, sc_pm[j * 64 + tl]);
            const float bc_t = sc_bc[j * 64 + tl];
            const float w_t = __expf(m - mm_t);
            const float einv_t = __expf(-(bc_t + mm_t));
            const int us = dir ? -1 : 1;
            int xq = (tl - 4 * g) * us;
            asm volatile("" : "+v"(xq));
            bf16x8 qf[4], kf0[4], kf1[4], cf[4];
#pragma unroll
            for (int ks = 0; ks < 4; ++ks) {
                qf[ks] = lds_frag(Qs, tl, ks * 2 + g);
                kf0[ks] = lds_frag(Ks, lr, ks * 2 + g);
                kf1[ks] = lds_frag(Ks, 32 + lr, ks * 2 + g);
                cf[ks] = lds_frag(Cs + cur * 8192, eb * 32 + lr, ks * 2 + g);
            }
            __builtin_amdgcn_sched_barrier(0);
            f32x16 sT[2], itv;
#pragma unroll
            for (int r = 0; r < 16; ++r) { sT[0][r] = 0.f; sT[1][r] = 0.f; itv[r] = 0.f; }
#pragma unroll
            for (int ks = 0; ks < 4; ++ks) {
                sT[0] = MFMA(kf0[ks], qf[ks], sT[0]);
                sT[1] = MFMA(kf1[ks], qf[ks], sT[1]);
                itv = MFMA(cf[ks], qf[ks], itv);
            }
            __builtin_amdgcn_sched_barrier(0);
            float qn = 0.f;
            {
                const float* ncur = n_s + cur * 64;
#pragma unroll
                for (int ks = 0; ks < 4; ++ks) {
                    const float4 n0v = *(const float4*)(ncur + ks * 16 + g * 8);
                    const float4 n1v = *(const float4*)(ncur + ks * 16 + g * 8 + 4);
                    qn += bf2f(qf[ks][0]) * n0v.x + bf2f(qf[ks][1]) * n0v.y + bf2f(qf[ks][2]) * n0v.z + bf2f(qf[ks][3]) * n0v.w;
                    qn += bf2f(qf[ks][4]) * n1v.x + bf2f(qf[ks][5]) * n1v.y + bf2f(qf[ks][6]) * n1v.z + bf2f(qf[ks][7]) * n1v.w;
                }
                qn += SX(qn, 32);
            }
            float cs = 0.f;
            f32x16 num;
            uint2 vta[4], vtb[4];
#pragma unroll
            for (int ksl = 0; ksl < 4; ++ksl) {
                vta[ksl] = *(const uint2*)(VTs + lds_off8(eb * 32 + lr, ksl * 16 + 4 * g));
                vtb[ksl] = *(const uint2*)(VTs + lds_off8(eb * 32 + lr, ksl * 16 + 8 + 4 * g));
            }
#pragma unroll
            for (int r = 0; r < 16; ++r) num[r] = itv[r] * w_t;
#pragma unroll
            for (int sb = 0; sb < 2; ++sb) {
#pragma unroll
                for (int hh = 0; hh < 2; ++hh) {
                    uint4 pu;
                    {
                        const int s0 = sb * 32 + 16 * hh + 4 * g;
                        const float4 av = *(const float4*)(a_s + s0);
                        const float4 bv = *(const float4*)(a_s + s0 + 8);
                        const int rb = 8 * hh;
                        const float p0 = sT[sb][rb + 0] * __expf(((sb * 32 + 16 * hh + 0) * us <= xq) ? (av.x - mm_t) : -1.0e30f);
                        const float p1 = sT[sb][rb + 1] * __expf(((sb * 32 + 16 * hh + 1) * us <= xq) ? (av.y - mm_t) : -1.0e30f);
                        const float p2 = sT[sb][rb + 2] * __expf(((sb * 32 + 16 * hh + 2) * us <= xq) ? (av.z - mm_t) : -1.0e30f);
                        const float p3 = sT[sb][rb + 3] * __expf(((sb * 32 + 16 * hh + 3) * us <= xq) ? (av.w - mm_t) : -1.0e30f);
                        const float p4 = sT[sb][rb + 4] * __expf(((sb * 32 + 16 * hh + 8) * us <= xq) ? (bv.x - mm_t) : -1.0e30f);
                        const float p5 = sT[sb][rb + 5] * __expf(((sb * 32 + 16 * hh + 9) * us <= xq) ? (bv.y - mm_t) : -1.0e30f);
                        const float p6 = sT[sb][rb + 6] * __expf(((sb * 32 + 16 * hh + 10) * us <= xq) ? (bv.z - mm_t) : -1.0e30f);
                        const float p7 = sT[sb][rb + 7] * __expf(((sb * 32 + 16 * hh + 11) * us <= xq) ? (bv.w - mm_t) : -1.0e30f);
                        cs += ((p0 + p1) + (p2 + p3)) + ((p4 + p5) + (p6 + p7));
                        pu = make_uint4(cvtpk(p0, p1), cvtpk(p2, p3), cvtpk(p4, p5), cvtpk(p6, p7));
                    }
                    const int ksl = sb * 2 + hh;
                    num = MFMA(u4_to_frag(make_uint4(vta[ksl].x, vta[ksl].y, vtb[ksl].x, vtb[ksl].y)), u4_to_frag(pu), num);
                }
            }
            cs += SX(cs, 32);
            {
                const float den = w_t * qn + cs;
                const float inv = __builtin_amdgcn_rcpf(fmaxf(fabsf(den), einv_t));
                unsigned short* hp = W.hdir() + (size_t)dir * NTOK * 256 + (size_t)(r0 + tl) * 256 + head * 64 + eb * 32 + 4 * g;
#pragma unroll
                for (int jj = 0; jj < 4; ++jj) {
                    uint2 o;
                    o.x = cvtpk(num[4 * jj] * inv, num[4 * jj + 1] * inv);
                    o.y = cvtpk(num[4 * jj + 2] * inv, num[4 * jj + 3] * inv);
                    *(uint2*)(hp + 8 * jj) = o;
                }
            }
        } else {
            if ((step & 3) == w4 && step + 4 < 132) {
                CHAIN_SCAN(step + 4);
                if (step + 8 < 132) CHAIN_GLOAD(step + 8);
            }
            wgw[lane] = __expf(a_s[lane] - M);
            asm volatile("s_waitcnt lgkmcnt(0)" ::: "memory");
#pragma unroll
            for (int r = 0; r < 16; ++r) CT[r] *= decay;
            float nsum = 0.f;
            bf16x8 kfs[4], vfs[4];
            float4 w0s[4], w1s[4];
#pragma unroll
            for (int ks = 0; ks < 4; ++ks) {
                kfs[ks] = lds_frag(KTs, tb * 32 + lr, ks * 2 + g);
                vfs[ks] = lds_frag(VTs, eb * 32 + lr, ks * 2 + g);
                w0s[ks] = *(const float4*)(wgw + ks * 16 + g * 8);
                w1s[ks] = *(const float4*)(wgw + ks * 16 + g * 8 + 4);
            }
            __builtin_amdgcn_sched_barrier(0);
#pragma unroll
            for (int ks = 0; ks < 4; ++ks) {
                const bf16x8 kf = kfs[ks];
                const float4 w0 = w0s[ks];
                const float4 w1 = w1s[ks];
                float e0 = bf2f(kf[0]) * w0.x, e1 = bf2f(kf[1]) * w0.y, e2 = bf2f(kf[2]) * w0.z, e3 = bf2f(kf[3]) * w0.w;
                float e4 = bf2f(kf[4]) * w1.x, e5 = bf2f(kf[5]) * w1.y, e6 = bf2f(kf[6]) * w1.z, e7 = bf2f(kf[7]) * w1.w;
                nsum += (e0 + e1) + (e2 + e3) + (e4 + e5) + (e6 + e7);
                const uint4 ku = make_uint4(cvtpk(e0, e1), cvtpk(e2, e3), cvtpk(e4, e5), cvtpk(e6, e7));
                CT = MFMA(u4_to_frag(ku), vfs[ks], CT);
            }
            nsum += SX(nsum, 32);
            if (eb == 0 && g == 0) n_s[nxt * 64 + tb * 32 + lr] = decay * n_s[cur * 64 + tb * 32 + lr] + nsum;
#pragma unroll
            for (int jj = 0; jj < 4; ++jj) {
                uint2 o;
                o.x = cvtpk(CT[4 * jj], CT[4 * jj + 1]);
                o.y = cvtpk(CT[4 * jj + 2], CT[4 * jj + 3]);
                *(uint2*)(Cs + nxt * 8192 + lds_off8(eb * 32 + lr, tb * 32 + 8 * jj + 4 * g)) = o;
            }
        }
        m = m_new;
        asm volatile("s_waitcnt lgkmcnt(0)" ::: "memory");
        __builtin_amdgcn_s_barrier();
        asm volatile("" ::: "memory");
        }
        {
            const int step = step0 + 1;
        const int cur = step & 1, nxt = cur ^ 1;
        const int j = step & 7;
        const int r0 = CHAIN_ROWBASE(step);
        if (step + 1 < 132) CHAIN_TILE_STOREB(nxt);
        if (step + 3 < 132) CHAIN_PREFETCHB(step + 3);
        const char* Qs = T + cur * 32768;
        const char* Ks = Qs + 8192;
        const char* KTs = Qs + 16384;
        const char* VTs = Qs + 24576;
        const float* a_s = sc_a + j * 64;
        const float b_end = sc_be[j];
        const float pmall = sc_pa[j];
        const float M = fmaxf(m, pmall);
        const float decay = __expf(m - M);
        const float m_new = b_end + M;
        const int tl = tb * 32 + lr;
        if (roleA) {
            const float mm_t = fmaxf(m, sc_pm[j * 64 + tl]);
            const float bc_t = sc_bc[j * 64 + tl];
            const float w_t = __expf(m - mm_t);
            const float einv_t = __expf(-(bc_t + mm_t));
            const int us = dir ? -1 : 1;
            int xq = (tl - 4 * g) * us;
            asm volatile("" : "+v"(xq));
            bf16x8 qf[4], kf0[4], kf1[4], cf[4];
#pragma unroll
            for (int ks = 0; ks < 4; ++ks) {
                qf[ks] = lds_frag(Qs, tl, ks * 2 + g);
                kf0[ks] = lds_frag(Ks, lr, ks * 2 + g);
                kf1[ks] = lds_frag(Ks, 32 + lr, ks * 2 + g);
                cf[ks] = lds_frag(Cs + cur * 8192, eb * 32 + lr, ks * 2 + g);
            }
            __builtin_amdgcn_sched_barrier(0);
            f32x16 sT[2], itv;
#pragma unroll
            for (int r = 0; r < 16; ++r) { sT[0][r] = 0.f; sT[1][r] = 0.f; itv[r] = 0.f; }
#pragma unroll
            for (int ks = 0; ks < 4; ++ks) {
                sT[0] = MFMA(kf0[ks], qf[ks], sT[0]);
                sT[1] = MFMA(kf1[ks], qf[ks], sT[1]);
                itv = MFMA(cf[ks], qf[ks], itv);
            }
            __builtin_amdgcn_sched_barrier(0);
            float qn = 0.f;
            {
                const float* ncur = n_s + cur * 64;
#pragma unroll
                for (int ks = 0; ks < 4; ++ks) {
                    const float4 n0v = *(const float4*)(ncur + ks * 16 + g * 8);
                    const float4 n1v = *(const float4*)(ncur + ks * 16 + g * 8 + 4);
                    qn += bf2f(qf[ks][0]) * n0v.x + bf2f(qf[ks][1]) * n0v.y + bf2f(qf[ks][2]) * n0v.z + bf2f(qf[ks][3]) * n0v.w;
                    qn += bf2f(qf[ks][4]) * n1v.x + bf2f(qf[ks][5]) * n1v.y + bf2f(qf[ks][6]) * n1v.z + bf2f(qf[ks][7]) * n1v.w;
                }
                qn += SX(qn, 32);
            }
            float cs = 0.f;
            f32x16 num;
            uint2 vta[4], vtb[4];
#pragma unroll
            for (int ksl = 0; ksl < 4; ++ksl) {
                vta[ksl] = *(const uint2*)(VTs + lds_off8(eb * 32 + lr, ksl * 16 + 4 * g));
                vtb[ksl] = *(const uint2*)(VTs + lds_off8(eb * 32 + lr, ksl * 16 + 8 + 4 * g));
            }
#pragma unroll
            for (int r = 0; r < 16; ++r) num[r] = itv[r] * w_t;
#pragma unroll
            for (int sb = 0; sb < 2; ++sb) {
#pragma unroll
                for (int hh = 0; hh < 2; ++hh) {
                    uint4 pu;
                    {
                        const int s0 = sb * 32 + 16 * hh + 4 * g;
                        const float4 av = *(const float4*)(a_s + s0);
                        const float4 bv = *(const float4*)(a_s + s0 + 8);
                        const int rb = 8 * hh;
                        const float p0 = sT[sb][rb + 0] * __expf(((sb * 32 + 16 * hh + 0) * us <= xq) ? (av.x - mm_t) : -1.0e30f);
                        const float p1 = sT[sb][rb + 1] * __expf(((sb * 32 + 16 * hh + 1) * us <= xq) ? (av.y - mm_t) : -1.0e30f);
                        const float p2 = sT[sb][rb + 2] * __expf(((sb * 32 + 16 * hh + 2) * us <= xq) ? (av.z - mm_t) : -1.0e30f);
                        const float p3 = sT[sb][rb + 3] * __expf(((sb * 32 + 16 * hh + 3) * us <= xq) ? (av.w - mm_t) : -1.0e30f);
                        const float p4 = sT[sb][rb + 4] * __expf(((sb * 32 + 16 * hh + 8) * us <= xq) ? (bv.x - mm_t) : -1.0e30f);
                        const float p5 = sT[sb][rb + 5] * __expf(((sb * 32 + 16 * hh + 9) * us <= xq) ? (bv.y - mm_t) : -1.0e30f);
                        const float p6 = sT[sb][rb + 6] * __expf(((sb * 32 + 16 * hh + 10) * us <= xq) ? (bv.z - mm_t) : -1.0e30f);
                        const float p7 = sT[sb][rb + 7] * __expf(((sb * 32 + 16 * hh + 11) * us <= xq) ? (bv.w - mm_t) : -1.0e30f);
                        cs += ((p0 + p1) + (p2 + p3)) + ((p4 + p5) + (p6 + p7));
                        pu = make_uint4(cvtpk(p0, p1), cvtpk(p2, p3), cvtpk(p4, p5), cvtpk(p6, p7));
                    }
                    const int ksl = sb * 2 + hh;
                    num = MFMA(u4_to_frag(make_uint4(vta[ksl].x, vta[ksl].y, vtb[ksl].x, vtb[ksl].y)), u4_to_frag(pu), num);
                }
            }
            cs += SX(cs, 32);
            {
                const float den = w_t * qn + cs;
                const float inv = __builtin_amdgcn_rcpf(fmaxf(fabsf(den), einv_t));
                unsigned short* hp = W.hdir() + (size_t)dir * NTOK * 256 + (size_t)(r0 + tl) * 256 + head * 64 + eb * 32 + 4 * g;
#pragma unroll
                for (int jj = 0; jj < 4; ++jj) {
                    uint2 o;
                    o.x = cvtpk(num[4 * jj] * inv, num[4 * jj + 1] * inv);
                    o.y = cvtpk(num[4 * jj + 2] * inv, num[4 * jj + 3] * inv);
                    *(uint2*)(hp + 8 * jj) = o;
                }
            }
        } else {
            if ((step & 3) == w4 && step + 4 < 132) {
                CHAIN_SCAN(step + 4);
                if (step + 8 < 132) CHAIN_GLOAD(step + 8);
            }
            wgw[lane] = __expf(a_s[lane] - M);
            asm volatile("s_waitcnt lgkmcnt(0)" ::: "memory");
#pragma unroll
            for (int r = 0; r < 16; ++r) CT[r] *= decay;
            float nsum = 0.f;
            bf16x8 kfs[4], vfs[4];
            float4 w0s[4], w1s[4];
#pragma unroll
            for (int ks = 0; ks < 4; ++ks) {
                kfs[ks] = lds_frag(KTs, tb * 32 + lr, ks * 2 + g);
                vfs[ks] = lds_frag(VTs, eb * 32 + lr, ks * 2 + g);
                w0s[ks] = *(const float4*)(wgw + ks * 16 + g * 8);
                w1s[ks] = *(const float4*)(wgw + ks * 16 + g * 8 + 4);
            }
            __builtin_amdgcn_sched_barrier(0);
#pragma unroll
            for (int ks = 0; ks < 4; ++ks) {
                const bf16x8 kf = kfs[ks];
                const float4 w0 = w0s[ks];
                const float4 w1 = w1s[ks];
                float e0 = bf2f(kf[0]) * w0.x, e1 = bf2f(kf[1]) * w0.y, e2 = bf2f(kf[2]) * w0.z, e3 = bf2f(kf[3]) * w0.w;
                float e4 = bf2f(kf[4]) * w1.x, e5 = bf2f(kf[5]) * w1.y, e6 = bf2f(kf[6]) * w1.z, e7 = bf2f(kf[7]) * w1.w;
                nsum += (e0 + e1) + (e2 + e3) + (e4 + e5) + (e6 + e7);
                const uint4 ku = make_uint4(cvtpk(e0, e1), cvtpk(e2, e3), cvtpk(e4, e5), cvtpk(e6, e7));
                CT = MFMA(u4_to_frag(ku), vfs[ks], CT);
            }
            nsum += SX(nsum, 32);
            if (eb == 0 && g == 0) n_s[nxt * 64 + tb * 32 + lr] = decay * n_s[cur * 64 + tb * 32 + lr] + nsum;
#pragma unroll
            for (int jj = 0; jj < 4; ++jj) {
                uint2 o;
                o.x = cvtpk(CT[4 * jj], CT[4 * jj + 1]);
                o.y = cvtpk(CT[4 * jj + 2], CT[4 * jj + 3]);
                *(uint2*)(Cs + nxt * 8192 + lds_off8(eb * 32 + lr, tb * 32 + 8 * jj + 4 * g)) = o;
            }
        }
        m = m_new;
        asm volatile("s_waitcnt lgkmcnt(0)" ::: "memory");
        __builtin_amdgcn_s_barrier();
        asm volatile("" ::: "memory");
        }
    }
    __builtin_amdgcn_s_setprio(0);
#undef CHAIN_ROWBASE
#undef CHAIN_PREFETCHA
#undef CHAIN_PREFETCHB
#undef CHAIN_TILE_STOREA
#undef CHAIN_TILE_STOREB
#undef CHAIN_SCAN
#undef CHAIN_GLOAD
}

DI void attn_item(const int wv, KP p, const int l_, const int item, const bool isctx, char* smem) {
    const int l = opaque_s(l_);
    const int tid = opaque_tid(wv), lane = tid & 63, w = tid >> 6, g = lane >> 5, lr = lane & 31;
    const int lrow = tid >> 3, lch = tid & 7;
    const WS W{p->ws};
    int b, kvh, q0, qrow0;
    if (!isctx) { b = item >> 8; kvh = (item >> 7) & 1; q0 = (item & 127) * 64; qrow0 = b * SEQ + q0; }
    else { b = item >> 3; kvh = (item >> 2) & 1; q0 = (item & 3) * 64; qrow0 = NLAT + b * CTXL + q0; }
    const int h = kvh * 4 + (w & 3);
    const int qb = w >> 2;
    char* KV = smem;
    char* Qw = smem + 32768 + w * 4096;
    LDS_BARRIER();
#pragma unroll
    for (int i = 0; i < 4; ++i) {
        const int row = (lane >> 3) + 8 * i, ch = lane & 7;
        *(uint4*)(Qw + lds_off(row, ch)) = *(const uint4*)(W.P() + (size_t)(qrow0 + qb * 32 + row) * PSTR + C_AQ + h * 64 + ch * 8);
    }
    const float sinkv = p->sink[l * 8 + h] * 1.44269504089f;
    float mrun = sinkv;
    float lrun = g == 0 ? 1.f : 0.f;
    f32x16 O0, O1;
#pragma unroll
    for (int r = 0; r < 16; ++r) { O0[r] = 0.f; O1[r] = 0.f; }
    int kstart = 0, ntl = 0;
    if (!isctx) {
        kstart = q0 - 128 < 0 ? 0 : q0 - 128;
        int kend = q0 + 192 > SEQ ? SEQ : q0 + 192;
        ntl = (kend - kstart) >> 6;
    }
    const unsigned short* kbase = W.P() + (size_t)lrow * PSTR + C_AK + kvh * 64 + lch * 8;
    const unsigned short* vbase = W.AVT() + (size_t)(kvh * 64 + lrow) * NTOK + lch * 8;
    uint4 kr0, vr0;
    const int ntot = ntl + 4;
    {
        const int krow_first = ntl > 0 ? b * SEQ + kstart : NLAT + b * CTXL;
        kr0 = *(const uint4*)(kbase + (size_t)krow_first * PSTR);
        vr0 = *(const uint4*)(vbase + krow_first);
    }
    *(uint4*)(KV + lds_off(lrow, lch)) = kr0;
    *(uint4*)(KV + 8192 + lds_off(lrow, lch)) = vr0;
    {
        const int krow_n = (1 < ntl) ? b * SEQ + kstart + 64 : NLAT + b * CTXL + (1 - ntl) * 64;
        kr0 = *(const uint4*)(kbase + (size_t)krow_n * PSTR);
        vr0 = *(const uint4*)(vbase + krow_n);
    }
    asm volatile("s_waitcnt lgkmcnt(0)" ::: "memory");
    __builtin_amdgcn_s_barrier();
    asm volatile("" ::: "memory");
    for (int tix = 0; tix < ntot; ++tix) {
        const bool local = tix < ntl;
        const int kpos0 = kstart + tix * 64;
        const char* Ks = KV + (tix & 1) * 16384;
        const char* VTs = Ks + 8192;
        if (tix + 1 < ntot) {
            char* kn = KV + ((tix + 1) & 1) * 16384;
            *(uint4*)(kn + lds_off(lrow, lch)) = kr0;
            *(uint4*)(kn + 8192 + lds_off(lrow, lch)) = vr0;
        }
        if (tix + 2 < ntot) {
            const int krow_n = (tix + 2 < ntl) ? b * SEQ + kpos0 + 128 : NLAT + b * CTXL + (tix + 2 - ntl) * 64;
            kr0 = *(const uint4*)(kbase + (size_t)krow_n * PSTR);
            vr0 = *(const uint4*)(vbase + krow_n);
        }
#pragma unroll
        for (int kb = 0; kb < 2; ++kb) {
            if (local) {
                const int k0b = kpos0 + kb * 32, q0b = q0 + qb * 32;
                if (k0b + 31 < q0b - 128 || k0b > q0b + 31 + 128) continue;
            }
            __builtin_amdgcn_sched_barrier(0);
            f32x16 s0;
#pragma unroll
            for (int r = 0; r < 16; ++r) s0[r] = 0.f;
            bf16x8 kfa[4], qfa[4];
            uint2 va0[2], va1[2], vb0[2], vb1[2];
#pragma unroll
            for (int ks = 0; ks < 4; ++ks) { kfa[ks] = lds_frag(Ks, kb * 32 + lr, ks * 2 + g); qfa[ks] = lds_frag(Qw, lr, ks * 2 + g); }
#pragma unroll
            for (int hh = 0; hh < 2; ++hh) {
                const int ksl = kb * 2 + hh;
                va0[hh] = *(const uint2*)(VTs + lds_off8(lr, ksl * 16 + 4 * g));
                va1[hh] = *(const uint2*)(VTs + lds_off8(lr, ksl * 16 + 8 + 4 * g));
                vb0[hh] = *(const uint2*)(VTs + lds_off8(32 + lr, ksl * 16 + 4 * g));
                vb1[hh] = *(const uint2*)(VTs + lds_off8(32 + lr, ksl * 16 + 8 + 4 * g));
            }
            __builtin_amdgcn_sched_barrier(0);
#pragma unroll
            for (int ks = 0; ks < 4; ++ks) s0 = MFMA(kfa[ks], qfa[ks], s0);
            if (local && (kpos0 < q0 - 64 || kpos0 > q0 + 64)) {
                const int dq = q0 + qb * 32 + lr - (kpos0 + kb * 32 + 4 * g);
#pragma unroll
                for (int r = 0; r < 16; ++r) {
                    const int d0 = dq - ((r & 3) + 8 * (r >> 2));
                    s0[r] = ((d0 <= 128) && (d0 >= -128)) ? s0[r] : -1.0e30f;
                }
            }
            float tmax = s0[0];
#pragma unroll
            for (int r = 1; r < 16; ++r) tmax = fmaxf(tmax, s0[r]);
            tmax = fmaxf(tmax, SX(tmax, 32));
            const float mnew = fmaxf(mrun, tmax);
            const float alpha = __builtin_amdgcn_exp2f(mrun - mnew);
            float ls = 0.f;
#pragma unroll
            for (int r = 0; r < 16; ++r) {
                s0[r] = __builtin_amdgcn_exp2f(s0[r] - mnew);
                ls += s0[r];
            }
            mrun = mnew;
            lrun = lrun * alpha + ls;
            if (__any(alpha != 1.f)) {
#pragma unroll
                for (int r = 0; r < 16; ++r) { O0[r] *= alpha; O1[r] *= alpha; }
            }
#pragma unroll
            for (int hh = 0; hh < 2; ++hh) {
                const uint4 pu = make_uint4(cvtpk(s0[8 * hh + 0], s0[8 * hh + 1]), cvtpk(s0[8 * hh + 2], s0[8 * hh + 3]), cvtpk(s0[8 * hh + 4], s0[8 * hh + 5]), cvtpk(s0[8 * hh + 6], s0[8 * hh + 7]));
                const bf16x8 pf = u4_to_frag(pu);
                O0 = MFMA(u4_to_frag(make_uint4(va0[hh].x, va0[hh].y, va1[hh].x, va1[hh].y)), pf, O0);
                O1 = MFMA(u4_to_frag(make_uint4(vb0[hh].x, vb0[hh].y, vb1[hh].x, vb1[hh].y)), pf, O1);
            }
        }
        asm volatile("s_waitcnt lgkmcnt(0)" ::: "memory");
        __builtin_amdgcn_s_barrier();
        asm volatile("" ::: "memory");
    }
    {
        const float lt = lrun + SX(lrun, 32);
        const float inv = 1.f / lt;
        unsigned short* op = W.mix() + (size_t)(qrow0 + qb * 32 + lr) * 1024 + 256 + h * 64 + 4 * g;
#pragma unroll
        for (int j = 0; j < 4; ++j) {
            uint2 o;
            o.x = cvtpk(O0[4 * j] * inv, O0[4 * j + 1] * inv);
            o.y = cvtpk(O0[4 * j + 2] * inv, O0[4 * j + 3] * inv);
            *(uint2*)(op + 8 * j) = o;
            o.x = cvtpk(O1[4 * j] * inv, O1[4 * j + 1] * inv);
            o.y = cvtpk(O1[4 * j + 2] * inv, O1[4 * j + 3] * inv);
            *(uint2*)(op + 32 + 8 * j) = o;
        }
    }
}

DI void conv_item(const int wv, KP p, const int l_, const int item, const bool isctx, char* smem) {
    const int l = opaque_s(l_);
    const int tid = opaque_tid(wv), lane = tid & 63, w = tid >> 6;
    const int c = tid & 255, half = tid >> 8;
    const WS W{p->ws};
    int rowbase, L, t0;
    if (!isctx) { const int b = item >> 7; rowbase = b * SEQ; L = SEQ; t0 = (item & 127) * 64; }
    else { const int b = item >> 2; rowbase = NLAT + b * CTXL; L = CTXL; t0 = (item & 3) * 64; }
    float* ys = (float*)smem;
    LDS_BARRIER();
    for (int u = tid; u < 94 * 32; u += 512) {
        const int rr = u >> 5, c8 = (u & 31) * 8;
        const int t = t0 - 15 + rr;
        float y[8];
        if (t >= 0 && t < L) {
            const uint4 av = *(const uint4*)(W.P() + (size_t)(rowbase + t) * PSTR + C_CV + c8);
            const uint4 gv = *(const uint4*)(W.P() + (size_t)(rowbase + t) * PSTR + C_CV + 256 + c8);
            y[0] = bflo(av.x) * sigmoid_f(bflo(gv.x)); y[1] = bfhi(av.x) * sigmoid_f(bfhi(gv.x));
            y[2] = bflo(av.y) * sigmoid_f(bflo(gv.y)); y[3] = bfhi(av.y) * sigmoid_f(bfhi(gv.y));
            y[4] = bflo(av.z) * sigmoid_f(bflo(gv.z)); y[5] = bfhi(av.z) * sigmoid_f(bfhi(gv.z));
            y[6] = bflo(av.w) * sigmoid_f(bflo(gv.w)); y[7] = bfhi(av.w) * sigmoid_f(bfhi(gv.w));
        } else {
#pragma unroll
            for (int i = 0; i < 8; ++i) y[i] = 0.f;
        }
        *(float4*)(ys + rr * 256 + c8) = make_float4(y[0], y[1], y[2], y[3]);
        *(float4*)(ys + rr * 256 + c8 + 4) = make_float4(y[4], y[5], y[6], y[7]);
    }
    float wj[31];
#pragma unroll
    for (int j = 0; j < 31; ++j) wj[j] = p->dw_w[(size_t)l * 31 * 256 + j * 256 + c];
    const float bias = p->dw_b[l * 256 + c];
    LDS_BARRIER();
    float z[32];
#pragma unroll
    for (int t = 0; t < 32; ++t) z[t] = bias;
    const float* ysh = ys + half * 32 * 256 + c;
#pragma unroll
    for (int rr = 0; rr < 62; ++rr) {
        const float yv = ysh[rr * 256];
#pragma unroll
        for (int t = 0; t < 32; ++t) {
            const int j = rr - t;
            if (j >= 0 && j < 31) z[t] += yv * wj[j];
        }
    }
    LDS_BARRIER();
#pragma unroll
    for (int t = 0; t < 32; ++t) ys[(half * 32 + t) * 256 + c] = z[t];
    LDS_BARRIER();
    const float4 lg = *(const float4*)(p->ln_g + l * 256 + lane * 4);
    const float4 lb = *(const float4*)(p->ln_b + l * 256 + lane * 4);
#pragma unroll
    for (int q = 0; q < 8; ++q) {
        const int t = w * 8 + q;
        const float4 zv = *(const float4*)(ys + t * 256 + lane * 4);
        float s = zv.x + zv.y + zv.z + zv.w;
#pragma unroll
        for (int o = 32; o >= 1; o >>= 1) s += SX(s, o);
        const float mu = s * (1.f / 256.f);
        const float d0 = zv.x - mu, d1 = zv.y - mu, d2 = zv.z - mu, d3 = zv.w - mu;
        float v = d0 * d0 + d1 * d1 + d2 * d2 + d3 * d3;
#pragma unroll
        for (int o = 32; o >= 1; o >>= 1) v += SX(v, o);
        const float rstd = rsqrtf(v * (1.f / 256.f) + EPS);
        const float o0 = silu_f(d0 * rstd * lg.x + lb.x), o1 = silu_f(d1 * rstd * lg.y + lb.y);
        const float o2 = silu_f(d2 * rstd * lg.z + lb.z), o3 = silu_f(d3 * rstd * lg.w + lb.w);
        uint2 o;
        o.x = cvtpk(o0, o1);
        o.y = cvtpk(o2, o3);
        *(uint2*)(W.mix() + (size_t)(rowbase + t0 + t) * 1024 + 768 + lane * 4) = o;
    }
}

DI void phase_mixers(const int wv, KP p, const int l, char* smem) {
    const int n_chain = 64;
    const int n_al = NB * 2 * 128;
    const int n_ac = (l == 0) ? NB * 2 * 4 : 0;
    const int n_cl = NB * 128;
    const int n_cc = (l == 0) ? NB * 4 : 0;
    const int total = n_chain + n_al + n_ac + n_cl + n_cc;
    int* slot = (int*)(smem + MISC_OFF + 64);
    const bool t0 = opaque_tid(wv) == 0;
    int nxt_item = 0;
    if (t0) nxt_item = (int)atomicAdd(WS{p->ws}.ctr() + l, 1u);
    for (;;) {
        LDS_BARRIER();
        if (t0) *slot = nxt_item;
        LDS_BARRIER();
        int it = *slot;
        if (it >= total) break;
        if (it < n_chain) {
            mlstm_chain(wv, p, l, it, smem);
            if (t0) nxt_item = (int)atomicAdd(WS{p->ws}.ctr() + l, 1u);
            continue;
        }
        if (t0) nxt_item = (int)atomicAdd(WS{p->ws}.ctr() + l, 1u);
        it -= n_chain;
        if (it < n_al) { attn_item(wv, p, l, it, false, smem); continue; }
        it -= n_al;
        if (it < n_ac) { attn_item(wv, p, l, it, true, smem); continue; }
        it -= n_ac;
        if (it < n_cl) { conv_item(wv, p, l, it, false, smem); continue; }
        it -= n_cl;
        conv_item(wv, p, l, it, true, smem);
    }
}

DI void phase_mfinal(const int wv, KP p, const int l) {
    const int tid = opaque_tid(wv);
    const int lane = tid & 63;
    const WS W{p->ws};
    const int nrows = (l == 0) ? NTOK : NLAT;
    const int rsub = tid >> 5, c8 = (tid & 31) * 8;
    const float4 g0 = *(const float4*)(p->head_gain + l * 256 + c8);
    const float4 g1 = *(const float4*)(p->head_gain + l * 256 + c8 + 4);
    const float gg[8] = {g0.x, g0.y, g0.z, g0.w, g1.x, g1.y, g1.z, g1.w};
    for (int rb = blockIdx.x; rb < nrows / 16; rb += gridDim.x) {
        const int r = rb * 16 + rsub;
        const uint4 a = *(const uint4*)(W.hdir() + (size_t)r * 256 + c8);
        const uint4 b = *(const uint4*)(W.hdir() + (size_t)NTOK * 256 + (size_t)r * 256 + c8);
        const uint4 ov = *(const uint4*)(W.P() + (size_t)r * PSTR + C_MO + c8);
        float hv[8], o8[8];
        hv[0] = bflo(a.x) + bflo(b.x); hv[1] = bfhi(a.x) + bfhi(b.x);
        hv[2] = bflo(a.y) + bflo(b.y); hv[3] = bfhi(a.y) + bfhi(b.y);
        hv[4] = bflo(a.z) + bflo(b.z); hv[5] = bfhi(a.z) + bfhi(b.z);
        hv[6] = bflo(a.w) + bflo(b.w); hv[7] = bfhi(a.w) + bfhi(b.w);
        o8[0] = bflo(ov.x); o8[1] = bfhi(ov.x); o8[2] = bflo(ov.y); o8[3] = bfhi(ov.y);
        o8[4] = bflo(ov.z); o8[5] = bfhi(ov.z); o8[6] = bflo(ov.w); o8[7] = bfhi(ov.w);
        float s = 0.f;
#pragma unroll
        for (int i = 0; i < 8; ++i) s += hv[i] * hv[i];
        s += SX(s, 1);
        s += SX(s, 2);
        s += SX(s, 4);
        const float rstd = rsqrtf(s * (1.f / 64.f) + EPS);
        float y[8];
#pragma unroll
        for (int i = 0; i < 8; ++i) y[i] = hv[i] * rstd * gg[i] * sigmoid_f(o8[i]);
        *(uint4*)(W.mix() + (size_t)r * 1024 + c8) = make_uint4(cvtpk(y[0], y[1]), cvtpk(y[2], y[3]), cvtpk(y[4], y[5]), cvtpk(y[6], y[7]));
    }
}

DI void phase_final(const int wv, KP p) {
    const int tid = opaque_tid(wv), lane = tid & 63, w = tid >> 6;
    for (int rb = blockIdx.x; rb < NLAT / 8; rb += gridDim.x) {
        const int r = rb * 8 + w;
        float* xp = p->out + (size_t)r * 1024;
        float4 v[4];
        float s = 0.f;
#pragma unroll
        for (int i = 0; i < 4; ++i) {
            v[i] = *(const float4*)(xp + i * 256 + lane * 4);
            s += v[i].x * v[i].x + v[i].y * v[i].y + v[i].z * v[i].z + v[i].w * v[i].w;
        }
#pragma unroll
        for (int o = 32; o >= 1; o >>= 1) s += SX(s, o);
        const float rstd = rsqrtf(s * (1.f / 1024.f) + EPS);
#pragma unroll
        for (int i = 0; i < 4; ++i) {
            const float4 gn = *(const float4*)(p->final_gain + i * 256 + lane * 4);
            *(float4*)(xp + i * 256 + lane * 4) = make_float4(v[i].x * rstd * gn.x, v[i].y * rstd * gn.y, v[i].z * rstd * gn.z, v[i].w * rstd * gn.w);
        }
    }
}

__global__ void __launch_bounds__(512, 2) fwd_megakernel(Params p_unused) {
    extern __shared__ __attribute__((aligned(16))) char smem[];
    cg::grid_group grid = cg::this_grid();
    const int wv = __builtin_amdgcn_readfirstlane((int)(threadIdx.x >> 6));
    volatile LAS unsigned* misc = (volatile LAS unsigned*)((LAS char*)smem + MISC_OFF);
    if (threadIdx.x < 16) misc[threadIdx.x] = 0u;
    __syncthreads();
    const KP p0 = (KP)__builtin_amdgcn_kernarg_segment_ptr();
    (void)xcd_barrier_post(WS{p0->ws}.bar(), misc);
#define GRID_BAR() do { XcdBarrier bar_; bar_.bar = WS{opaque_kp(p0)->ws}.bar(); bar_.x = xb_xcc_id(); bar_.st = (volatile LAS unsigned*)((LAS char*)smem + MISC_OFF); xcd_barrier(bar_, opaque_tid(wv) == 0); } while (0)
    phase0a(wv, opaque_kp(p0), smem);
    if (p0->ws == nullptr) grid.sync();
    GRID_BAR();
    phase0c(wv, opaque_kp(p0), smem);
    GRID_BAR();
#pragma unroll 1
    for (int l = 0; l < 2; ++l) {
        const int M = (l == 0) ? NTOK : NLAT;
        {
            const KP p = opaque_kp(p0);
            const WS W{p->ws};
            EpiInproj E; E.ws = p->ws; E.l = l;
            run_gemm(smem, W.xg(), W.WtIn() + (size_t)l * NP * 1024, NTOK, NP, 1024, E);
            fill_tail(wv, p, l == 0 ? 0 : 3, (NTOK / 256) * (NP / 256) - 10 * 256, smem);
        }
        GRID_BAR();
        phase_mixers(wv, opaque_kp(p0), l, smem);
        GRID_BAR();
        phase_mfinal(wv, opaque_kp(p0), l);
        GRID_BAR();
        {
            const KP p = opaque_kp(p0);
            const WS W{p->ws};
            EpiResid E;
            E.xold_lat = (l == 0) ? p->x : p->out; E.xold_ctx = (l == 0) ? p->ctx : W.ctxa();
            E.xnew_lat = p->out; E.xnew_ctx = W.ctxa();
            E.gate = W.modv() + (size_t)((l * 6 + 2) * 9) * 1024;
            E.Gnext = W.modv() + (size_t)((l * 6 + 4) * 9) * 1024;
            E.xg = W.xg();
            E.rsq = W.rowsq() + (size_t)(l * 2 + 1) * NTOK;
            run_gemm(smem, W.mix(), W.WtOut() + (size_t)l * 1024 * 1024, M, 1024, 1024, E);
            if (l == 0) fill_tail(wv, p, 1, (NTOK / 256) * 4 - 4 * 256, smem);
        }
        GRID_BAR();
        {
            const KP p = opaque_kp(p0);
            const WS W{p->ws};
            EpiFfnin E; E.ws = p->ws; E.l = l;
            run_gemm(smem, W.xg(), W.WtF1() + (size_t)l * FFN2 * 1024, M, FFN2, 1024, E);
        }
        GRID_BAR();
        {
            const KP p = opaque_kp(p0);
            const WS W{p->ws};
            EpiResid E;
            E.xold_lat = p->out; E.xold_ctx = W.ctxa();
            E.xnew_lat = p->out; E.xnew_ctx = W.ctxa();
            E.gate = W.modv() + (size_t)((l * 6 + 5) * 9) * 1024;
            E.Gnext = (l == 0) ? W.modv() + (size_t)((1 * 6 + 1) * 9) * 1024 : nullptr;
            E.xg = W.xg();
            E.rsq = (l == 0) ? W.rowsq() + (size_t)2 * NTOK : nullptr;
            run_gemm(smem, W.hid(), W.WtF2() + (size_t)l * 1024 * FFN, M, 1024, FFN, E);
            if (l == 0) fill_tail(wv, p, 2, (NTOK / 256) * 4 - 4 * 256, smem);
        }
        GRID_BAR();
    }
    phase_final(wv, opaque_kp(p0));
}

extern "C" void kernel_launch(void* const* d_in, const int* in_sizes, int n_in, void* d_out, int out_size, void* d_ws,
                              size_t ws_size, hipStream_t stream) {
    static int grid_blocks = 0;
    if (!grid_blocks) {
        int dev = 0, cus = 0;
        (void)hipGetDevice(&dev);
        (void)hipDeviceGetAttribute(&cus, hipDeviceAttributeMultiprocessorCount, dev);
        if (hipFuncSetAttribute((const void*)fwd_megakernel, hipFuncAttributeMaxDynamicSharedMemorySize, LDS_BYTES) != hipSuccess)
            fprintf(stderr, "hipFuncSetAttribute(MaxDynamicSharedMemorySize) failed\n");
        int per_cu = 0;
        if (hipOccupancyMaxActiveBlocksPerMultiprocessor(&per_cu, (const void*)fwd_megakernel, 512, LDS_BYTES) != hipSuccess || per_cu < 1)
            fprintf(stderr, "occupancy query says %d blocks per CU\n", per_cu);
        (void)hipGetLastError();
        grid_blocks = cus > 0 ? cus : 256;
    }
    Params p{};
    p.x = (const float*)d_in[0]; p.c = (const float*)d_in[1]; p.ctx = (const float*)d_in[2]; p.c_ctx = (const float*)d_in[3];
    p.w_mod = (const float*)d_in[4]; p.b_mod = (const float*)d_in[5]; p.norm_gain = (const float*)d_in[6]; p.w_in = (const float*)d_in[7];
    p.gate_bias = (const float*)d_in[8]; p.head_gain = (const float*)d_in[9]; p.sink = (const float*)d_in[10];
    p.dw_w = (const float*)d_in[11]; p.dw_b = (const float*)d_in[12]; p.ln_g = (const float*)d_in[13]; p.ln_b = (const float*)d_in[14];
    p.pw_w = (const float*)d_in[15]; p.w_out = (const float*)d_in[16]; p.w_ffn_in = (const float*)d_in[17]; p.w_ffn_out = (const float*)d_in[18];
    p.final_gain = (const float*)d_in[19];
    p.out = (float*)d_out;
    p.ws = (char*)d_ws;
    if (O_END > ws_size) fprintf(stderr, "workspace too small: need %zu have %zu\n", (size_t)O_END, ws_size);
    (void)hipMemsetAsync((char*)d_ws + O_CTR, 0, (O_ROWSQ - O_CTR) + (size_t)5 * NTOK * 4, stream);
    void* args[] = {&p};
    hipError_t e = hipLaunchCooperativeKernel((void*)fwd_megakernel, dim3(grid_blocks), dim3(512), args, LDS_BYTES, stream);
    if (e != hipSuccess) fprintf(stderr, "cooperative launch failed: %s (grid %d)\n", hipGetErrorString(e), grid_blocks);
}
```

```cpp
#include <hip/hip_runtime.h>
#include <hip/hip_cooperative_groups.h>
#include <cstdio>
#include <cstdint>
namespace cg = cooperative_groups;

#define DI __device__ __forceinline__
typedef __attribute__((ext_vector_type(8))) short bf16x8;
typedef __attribute__((ext_vector_type(16))) float f32x16;
#define MFMA(a, b, c) __builtin_amdgcn_mfma_f32_32x32x16_bf16((a), (b), (c), 0, 0, 0)

constexpr int DM = 1024;
constexpr int NB = 8;
constexpr int SEQ = 8192;
constexpr int CTXL = 256;
constexpr int NLAT = NB * SEQ;
constexpr int NCTX = NB * CTXL;
constexpr int NTOK = NLAT + NCTX;
constexpr int INC = 2320;
constexpr int NP = 2560;
constexpr int PSTR = 2304;
constexpr int FFN = 2816;
constexpr int FFN2 = 5632;
constexpr int C_MQ = 0, C_MK = 256, C_MV = 512, C_MO = 768, C_AQ = 1024, C_AK = 1536, C_AV = 1664, C_CV = 1792;
constexpr float EPS = 1e-6f;

constexpr size_t al256(size_t v) { return (v + 255) & ~(size_t)255; }
constexpr size_t O_WTIN = 0;
constexpr size_t O_WTOUT = O_WTIN + al256((size_t)2 * NP * 1024 * 2);
constexpr size_t O_WTF1 = O_WTOUT + al256((size_t)2 * 1024 * 1024 * 2);
constexpr size_t O_WTF2 = O_WTF1 + al256((size_t)2 * FFN2 * 1024 * 2);
constexpr size_t O_MODV = O_WTF2 + al256((size_t)2 * 1024 * FFN * 2);
constexpr size_t O_SHW1 = O_MODV + al256((size_t)2 * 6 * 9 * 1024 * 4);
constexpr size_t O_SHW2 = O_SHW1 + al256((size_t)2 * 9 * NP * 4);
constexpr size_t O_ROPE = O_SHW2 + al256((size_t)2 * 9 * FFN2 * 4);
constexpr size_t O_CTR = O_ROPE + al256((size_t)128 * 16 * 2 * 4);
constexpr size_t O_BAR = O_CTR + 256;
constexpr size_t O_ROWSQ = O_BAR + 16384;
constexpr size_t O_XG = O_ROWSQ + al256((size_t)5 * NTOK * 4);
constexpr size_t O_CTXA = O_XG + al256((size_t)NTOK * 1024 * 2);
constexpr size_t O_MIX = O_CTXA + al256((size_t)NCTX * 1024 * 4);
constexpr size_t O_P = O_MIX + al256((size_t)NTOK * 1024 * 2);
constexpr size_t O_MKT = O_P + al256((size_t)NTOK * PSTR * 2);
constexpr size_t O_MVT = O_MKT + al256((size_t)256 * NTOK * 2);
constexpr size_t O_AVT = O_MVT + al256((size_t)256 * NTOK * 2);
constexpr size_t O_GATES = O_AVT + al256((size_t)128 * NTOK * 2);
constexpr size_t O_HDIR = O_GATES + al256((size_t)NTOK * 16 * 4);
constexpr size_t O_END = O_HDIR + al256((size_t)2 * NTOK * 256 * 2);
constexpr size_t O_HID = O_P;
static_assert(O_HID + (size_t)NTOK * FFN * 2 <= O_END, "hid alias overflow");

struct Params {
    const float *x, *c, *ctx, *c_ctx, *w_mod, *b_mod, *norm_gain, *w_in, *gate_bias, *head_gain, *sink,
        *dw_w, *dw_b, *ln_g, *ln_b, *pw_w, *w_out, *w_ffn_in, *w_ffn_out, *final_gain;
    float* out;
    char* ws;
};
typedef const Params __attribute__((address_space(4)))* KP;
DI KP opaque_kp(KP q) { asm volatile("" : "+s"(q)); return q; }
struct WS {
    char* b;
    DI unsigned short* WtIn() const { return (unsigned short*)(b + O_WTIN); }
    DI unsigned short* WtOut() const { return (unsigned short*)(b + O_WTOUT); }
    DI unsigned short* WtF1() const { return (unsigned short*)(b + O_WTF1); }
    DI unsigned short* WtF2() const { return (unsigned short*)(b + O_WTF2); }
    DI float* modv() const { return (float*)(b + O_MODV); }
    DI float* shW1() const { return (float*)(b + O_SHW1); }
    DI float* shW2() const { return (float*)(b + O_SHW2); }
    DI float* rope() const { return (float*)(b + O_ROPE); }
    DI unsigned* ctr() const { return (unsigned*)(b + O_CTR); }
    DI unsigned* bar() const { return (unsigned*)(b + O_BAR); }
    DI float* rowsq() const { return (float*)(b + O_ROWSQ); }
    DI unsigned short* xg() const { return (unsigned short*)(b + O_XG); }
    DI float* ctxa() const { return (float*)(b + O_CTXA); }
    DI unsigned short* mix() const { return (unsigned short*)(b + O_MIX); }
    DI unsigned short* P() const { return (unsigned short*)(b + O_P); }
    DI unsigned short* MKT() const { return (unsigned short*)(b + O_MKT); }
    DI unsigned short* MVT() const { return (unsigned short*)(b + O_MVT); }
    DI unsigned short* AVT() const { return (unsigned short*)(b + O_AVT); }
    DI float* gates() const { return (float*)(b + O_GATES); }
    DI unsigned short* hdir() const { return (unsigned short*)(b + O_HDIR); }
    DI unsigned short* hid() const { return (unsigned short*)(b + O_HID); }
};

DI int opaque_tid(int wv) { int t = wv * 64 + (int)__builtin_amdgcn_mbcnt_hi(~0u, __builtin_amdgcn_mbcnt_lo(~0u, 0u)); asm volatile("" : "+v"(t)); return t; }
DI int opaque_s(int v) { asm volatile("" : "+s"(v)); return v; }
DI unsigned cvtpk(float lo, float hi) { unsigned r; asm("v_cvt_pk_bf16_f32 %0, %1, %2" : "=v"(r) : "v"(lo), "v"(hi)); return r; }
DI float bflo(unsigned u) { return __uint_as_float(u << 16); }
DI float bfhi(unsigned u) { return __uint_as_float(u & 0xffff0000u); }
DI float bf2f(short s) { return __uint_as_float(((unsigned)(unsigned short)s) << 16); }
DI int lds_off(int row, int chunk) { return row * 128 + ((chunk ^ ((row >> 1) & 7)) << 4); }
DI int lds_off8(int row, int k) { return row * 128 + ((((k >> 3)) ^ ((row >> 1) & 7)) << 4) + ((k & 7) << 1); }
DI bf16x8 lds_frag(const char* base, int row, int chunk) { return *(const bf16x8*)(base + lds_off(row, chunk)); }
DI bf16x8 u4_to_frag(uint4 v) { return __builtin_bit_cast(bf16x8, v); }
DI float shfl_i(float v, int srclane) { return __int_as_float(__builtin_amdgcn_ds_bpermute(srclane << 2, __float_as_int(v))); }
#define SX(v, m) shfl_i((v), lane ^ (m))
#define LDS_BARRIER() do { asm volatile("s_waitcnt lgkmcnt(0)" ::: "memory"); __builtin_amdgcn_s_barrier(); asm volatile("" ::: "memory"); } while (0)
DI float silu_f(float v) { return v * __builtin_amdgcn_rcpf(1.f + __expf(-v)); }
DI float sigmoid_f(float v) { return __builtin_amdgcn_rcpf(1.f + __expf(-v)); }


namespace pg8 {
#define PG8_LAS __attribute__((address_space(3)))
typedef unsigned short bf16_t;
typedef short bf16x8 __attribute__((ext_vector_type(8)));
typedef float f32x4 __attribute__((ext_vector_type(4)));
typedef unsigned u32x4 __attribute__((ext_vector_type(4)));
constexpr int BM = 256, BK = 64, HALF = 128, HTB = HALF * BK * 2  , STAGE_BYTES = 8 * HTB, NXCD = 8, WGM = 8;

__host__ __device__ __forceinline__ int lds_byte(int r, int c) { const int st = (r >> 4) * 2 + (c >> 5), rr = r & 15, cc = c & 31, ob = rr * 64 + cc * 2; return st * 1024 + (ob ^ (((ob >> 9) & 1) << 5)); }
__host__ __device__ __forceinline__ void stage_rc(int b, int& R, int& C) { const int st = b / 1024, sb = b % 1024, swz = sb ^ (((sb >> 9) & 1) << 5); R = (st >> 1) * 16 + swz / 64; C = (st & 1) * 32 + (swz % 64) / 2; }
__host__ __device__ __forceinline__ int perm32(int rho) { const int n = rho >> 4, i = rho & 15; return 8 * (i >> 2) + 4 * n + (i & 3); }

struct Unit { int pm, pn; };
struct Gemm { const bf16_t* A; const bf16_t* Bt; int M, N, K; };

struct StaticOrder {
    int nM, nN, nwg, G, c;
    __host__ __device__ void init(int M, int N, int G_, int c_) { nM = M / BM; nN = N / BM; nwg = nM * nN; G = G_; c = c_; }
    __host__ __device__ bool next(int i, Unit& u) const {
        const long L = (long)i * G + c; if (L >= nwg) return false;
        int wgid = (int)L; { const int q = nwg / NXCD, r = nwg % NXCD, xcd = wgid % NXCD, off = wgid / NXCD; wgid = (xcd < r ? xcd * (q + 1) : r * (q + 1) + (xcd - r) * q) + off; }
        const int nig = WGM * nN, gid = wgid / nig, fm = gid * WGM, gsz = (nM - fm) < WGM ? (nM - fm) : WGM;
        u.pm = fm + ((wgid % nig) % gsz); u.pn = (wgid % nig) / gsz; return true;
    }
    __device__ __forceinline__ void a_ready(const Unit&) const {}
    __device__ __forceinline__ void done(const Unit&) const {}
};
template <class Epi, class Sched, bool STAMP = false>
__device__ __forceinline__ void gemm_phase(PG8_LAS unsigned char* lds, const Gemm g, const Sched& S, const Epi& E, unsigned long long* stamps) {
    int tid_o = threadIdx.x; asm volatile("" : "+v"(tid_o));
    const int tid = tid_o, wid = __builtin_amdgcn_readfirstlane(tid >> 6), lane = tid & 63, wr = wid >> 2, wc = wid & 3, fr = lane & 15, fq = lane >> 4;
    const int K = g.K, nt = K / BK;
    int ts_lo = 0, ts_hi = 0, nts = 0; const unsigned long long rt_entry = STAMP ? (unsigned long long)wall_clock64() : 0ull;
#define PG8_STAMP() do { if (STAMP && wid == 0 && nts < 64) { const unsigned long long _c = (unsigned long long)clock64(); \
        ts_lo = (lane == nts) ? (int)(unsigned)_c : ts_lo; ts_hi = (lane == nts) ? (int)(unsigned)(_c >> 32) : ts_hi; ++nts; } } while (0)
    PG8_STAMP();
    unsigned voffA[2], voffB[2];
#pragma unroll
    for (int i = 0; i < 2; ++i) { int R, C; stage_rc(tid * 16 + i * 8192, R, C); const int Rb = Epi::PERM ? ((R & ~31) + perm32(R & 31)) : R;
        voffA[i] = (unsigned)(R * K + C) * 2u; voffB[i] = (unsigned)(Rb * K + C) * 2u; }
    const size_t kstep = (size_t)(BK * 2);
    const size_t hstep = (size_t)HALF * K * 2;
    const size_t tstep = 2 * hstep;
    const unsigned ldsw = (unsigned)wid * 1024u;
    const int aoff = lds_byte(wr * 64 + fr, fq * 8), boff = lds_byte(wc * 32 + fr, fq * 8);
#define PG8_SA(b, h) (((b) * 2 + (h)) * HTB)
#define PG8_SB(b, h) ((4 + (b) * 2 + (h)) * HTB)
#define PG8_STAGE(bufoff, gbase, voff) do { _Pragma("unroll") for (int _i = 0; _i < 2; ++_i) \
        __builtin_amdgcn_global_load_lds((const unsigned*)((const char*)(gbase) + (voff)[_i]), (PG8_LAS unsigned*)(lds + (bufoff) + ldsw + _i * 8192), 16, 0, 0); } while (0)
#define PG8_LDA(dst, b, h) do { _Pragma("unroll") for (int m = 0; m < 4; ++m) _Pragma("unroll") for (int k = 0; k < 2; ++k) dst[m][k] = *(const PG8_LAS bf16x8*)(lds + PG8_SA(b, h) + aoff + m * 2048 + k * 1024); } while (0)
#define PG8_LDB(dst, b, h) do { _Pragma("unroll") for (int n = 0; n < 2; ++n) _Pragma("unroll") for (int k = 0; k < 2; ++k) dst[n][k] = *(const PG8_LAS bf16x8*)(lds + PG8_SB(b, h) + boff + n * 2048 + k * 1024); } while (0)
#define PG8_MMA(ai, bj, At, Bt) do { __builtin_amdgcn_s_setprio(1); _Pragma("unroll") for (int m = 0; m < 4; ++m) _Pragma("unroll") for (int n = 0; n < 2; ++n) _Pragma("unroll") for (int k = 0; k < 2; ++k) \
        acc[ai][bj][m][n] = __builtin_amdgcn_mfma_f32_16x16x32_bf16(Bt[n][k], At[m][k], acc[ai][bj][m][n], 0, 0, 0); __builtin_amdgcn_s_setprio(0); } while (0)
#define PG8_WAIT_V(n) asm volatile("s_waitcnt vmcnt(" #n ")" ::: "memory")
#define PG8_WAIT_L(n) asm volatile("s_waitcnt lgkmcnt(" #n ")" ::: "memory")
#define PG8_BAR __builtin_amdgcn_s_barrier()
#define PG8_SCHED __builtin_amdgcn_sched_barrier(0)
    Unit cur, nxt; int ui = 0;
    if (!S.next(0, cur)) return;
    f32x4 acc[2][2][4][2];
#pragma unroll
    for (int a = 0; a < 2; ++a)
#pragma unroll
        for (int b = 0; b < 2; ++b)
#pragma unroll
            for (int m = 0; m < 4; ++m)
#pragma unroll
                for (int n = 0; n < 2; ++n) acc[a][b][m][n] = (f32x4){0.f, 0.f, 0.f, 0.f};
    bf16x8 At[4][2], B0[2][2], B1[2][2];
    const char* cA = (const char*)g.A + (size_t)cur.pm * tstep; const char* cB = (const char*)g.Bt + (size_t)cur.pn * tstep;
    S.a_ready(cur);
    PG8_STAGE(PG8_SB(0, 0), cB, voffB); PG8_STAGE(PG8_SA(0, 0), cA, voffA); PG8_STAGE(PG8_SB(0, 1), cB + hstep, voffB); PG8_STAGE(PG8_SA(0, 1), cA + hstep, voffA);
    if (wr == 1) PG8_BAR;
    PG8_WAIT_V(4); PG8_BAR;
    PG8_STAGE(PG8_SB(1, 0), cB + kstep, voffB); PG8_STAGE(PG8_SA(1, 0), cA + kstep, voffA); PG8_STAGE(PG8_SB(1, 1), cB + hstep + kstep, voffB);
    PG8_WAIT_V(6); PG8_BAR;
    PG8_STAMP();
    for (;;) {
        const bool has_next = S.next(ui + 1, nxt);
        const char* nA = has_next ? (const char*)g.A + (size_t)nxt.pm * tstep : cA; const char* nB = has_next ? (const char*)g.Bt + (size_t)nxt.pn * tstep : cB;
        for (int t = 0; t < nt; t += 2) {
            const bool last = (t == nt - 2);
            const char* a1 = cA + (size_t)(t + 1) * kstep;
            const char* a2 = last ? nA : cA + (size_t)(t + 2) * kstep; const char* b2 = last ? nB : cB + (size_t)(t + 2) * kstep;
            const char* a3 = a2 + kstep; const char* b3 = b2 + kstep;
            if (last && has_next) S.a_ready(nxt);
            PG8_LDB(B0, 0, 0); PG8_SCHED; PG8_LDA(At, 0, 0); PG8_STAGE(PG8_SA(1, 1), a1 + hstep, voffA);
            PG8_WAIT_L(8); PG8_BAR; PG8_WAIT_L(0); PG8_MMA(0, 0, At, B0); PG8_BAR; PG8_SCHED;
            PG8_LDB(B1, 0, 1); PG8_STAGE(PG8_SB(0, 0), b2, voffB);
            PG8_BAR; PG8_WAIT_L(0); PG8_MMA(0, 1, At, B1); PG8_BAR;
            PG8_LDA(At, 0, 1); PG8_STAGE(PG8_SA(0, 0), a2, voffA);
            PG8_BAR; PG8_WAIT_L(0); PG8_MMA(1, 0, At, B0); PG8_BAR; PG8_SCHED;
            PG8_STAGE(PG8_SB(0, 1), b2 + hstep, voffB);
            PG8_WAIT_V(6); PG8_BAR; PG8_MMA(1, 1, At, B1); PG8_BAR;
            PG8_LDB(B0, 1, 0); PG8_SCHED; PG8_LDA(At, 1, 0); PG8_STAGE(PG8_SA(0, 1), a2 + hstep, voffA);
            PG8_WAIT_L(8); PG8_BAR; PG8_WAIT_L(0); PG8_MMA(0, 0, At, B0); PG8_BAR; PG8_SCHED;
            PG8_LDB(B1, 1, 1); PG8_STAGE(PG8_SB(1, 0), b3, voffB);
            PG8_BAR; PG8_WAIT_L(0); PG8_MMA(0, 1, At, B1); PG8_BAR;
            PG8_LDA(At, 1, 1); PG8_STAGE(PG8_SA(1, 0), a3, voffA);
            PG8_BAR; PG8_WAIT_L(0); PG8_MMA(1, 0, At, B0); PG8_BAR; PG8_SCHED;
            PG8_STAGE(PG8_SB(1, 1), b3 + hstep, voffB);
            PG8_WAIT_V(6); PG8_BAR; PG8_MMA(1, 1, At, B1); PG8_BAR;
        }
        PG8_STAMP();
        if constexpr (!Epi::AFTER_DRAIN) { E(acc, cur, wr, wc, fr, fq); S.done(cur); }
        PG8_STAMP();
        if (!has_next) break;
#pragma unroll
        for (int a = 0; a < 2; ++a)
#pragma unroll
            for (int b = 0; b < 2; ++b)
#pragma unroll
                for (int m = 0; m < 4; ++m)
#pragma unroll
                    for (int n = 0; n < 2; ++n) acc[a][b][m][n] = (f32x4){0.f, 0.f, 0.f, 0.f};
        cur = nxt; cA = nA; cB = nB; ++ui;
    }
    PG8_WAIT_V(0);
    if (wr == 0) PG8_BAR;
    PG8_BAR;
    if constexpr (Epi::AFTER_DRAIN) { E.fused(acc, cur, wr, wc, fr, fq, lds, wid, lane); S.done(cur); }
    PG8_STAMP();
    if (STAMP && wid == 0) { stamps[lane] = lane < nts ? (((unsigned long long)(unsigned)ts_hi << 32) | (unsigned)ts_lo) : 0ull;
        if (lane == 62) stamps[62] = rt_entry; if (lane == 63) stamps[63] = (unsigned long long)wall_clock64(); }
#undef PG8_STAMP
#undef PG8_SA
#undef PG8_SB
#undef PG8_STAGE
#undef PG8_LDA
#undef PG8_LDB
#undef PG8_MMA
#undef PG8_WAIT_V
#undef PG8_WAIT_L
#undef PG8_BAR
#undef PG8_SCHED
}
}
using pg8::f32x4;
using pg8::Unit;
#define LAS __attribute__((address_space(3)))

#define XB_TMO      128
#define XB_XCNT(j)  (256  + 64 * (j))
#define XB_XSUB(j)  (1280 + 64 * (j))
#define XB_XGEN(j)  (2304 + 64 * (j))
#define XB_TOP      3328
#define XB_TOPGEN   3392
#define XCD_BAR_WORDS 3456
#define XB_SPIN_CAP (1u << 18)

__device__ __forceinline__ unsigned xb_ld(unsigned* p)              { return __hip_atomic_load(p, __ATOMIC_RELAXED, __HIP_MEMORY_SCOPE_AGENT); }
__device__ __forceinline__ unsigned xb_add(unsigned* p, unsigned v) { return __hip_atomic_fetch_add(p, v, __ATOMIC_RELAXED, __HIP_MEMORY_SCOPE_AGENT); }
__device__ __forceinline__ unsigned xb_xcc_id() { return (unsigned)__builtin_amdgcn_s_getreg((3 << 11) | 20) & 0xFu; }
#define XB_SPIN(cond, bar) do { unsigned _sp = 0; while (cond) { __builtin_amdgcn_s_sleep(1); \
    if ((++_sp & 255u) == 0u) { if (xb_ld(&(bar)[XB_TMO])) break; if (_sp > XB_SPIN_CAP) { atomicAdd(&(bar)[XB_TMO], 1u); break; } } } } while (0)

struct XcdBarrier {
    unsigned* bar; unsigned x;
    volatile LAS unsigned* st;
};

__device__ __forceinline__ XcdBarrier xcd_barrier_post(unsigned* bar, volatile LAS unsigned* st) {
    XcdBarrier b; b.bar = bar; b.x = xb_xcc_id(); b.st = st;
    if (threadIdx.x == 0) (void)xb_add(&bar[XB_XCNT(b.x)], 1u);
    return b;
}
__device__ __forceinline__ void xcd_barrier_complete(unsigned* bar, unsigned x, unsigned& nloc, unsigned& nx) {
    const unsigned G = gridDim.x * gridDim.y * gridDim.z;
    unsigned sum, cnt, mine, sp = 0u;
    for (;;) {
        sum = 0u; cnt = 0u; mine = 0u;
#pragma unroll
        for (unsigned j = 0; j < 16; ++j) { const unsigned c = xb_ld(&bar[XB_XCNT(j)]); sum += c; cnt += (c > 0u) ? 1u : 0u; mine = (j == x) ? c : mine; }
        if (sum == G) break;
        __builtin_amdgcn_s_sleep(1);
        if ((++sp & 255u) == 0u) { if (xb_ld(&bar[XB_TMO])) break; if (sp > XB_SPIN_CAP) { atomicAdd(&bar[XB_TMO], 1u); break; } }
    }
    nloc = mine > 0u ? mine : 1u; nx = cnt > 0u ? cnt : 1u;
}

__device__ __forceinline__ void xcd_barrier(const XcdBarrier& b, const bool leader_thread) {
    asm volatile("s_waitcnt vmcnt(0)" ::: "memory");
    __syncthreads();
    if (leader_thread) {
        unsigned* bar = b.bar;
        __builtin_amdgcn_s_waitcnt(0);
        unsigned nloc = b.st[0], nx = b.st[1];
        if (nloc == 0u) { xcd_barrier_complete(bar, b.x, nloc, nx); b.st[0] = nloc; b.st[1] = nx; }
        const unsigned old = xb_add(&bar[XB_XSUB(b.x)], 1u);
        const unsigned gen = old / nloc;
        if (old + 1u == (gen + 1u) * nloc) {
            __builtin_amdgcn_fence(__ATOMIC_RELEASE, "agent");
            asm volatile("s_waitcnt vmcnt(0)" ::: "memory");
            const unsigned og = xb_add(&bar[XB_TOP], 1u);
            const unsigned tg = og / nx;
            if (og + 1u == (tg + 1u) * nx) xb_add(&bar[XB_TOPGEN], 1u);
            else XB_SPIN(xb_ld(&bar[XB_TOPGEN]) == tg, bar);
            __builtin_amdgcn_fence(__ATOMIC_ACQUIRE, "agent");
            xb_add(&bar[XB_XGEN(b.x)], 1u);
            asm volatile("s_waitcnt vmcnt(0)" ::: "memory");
        } else {
            XB_SPIN(xb_ld(&bar[XB_XGEN(b.x)]) == gen, bar);
            __builtin_amdgcn_fence(__ATOMIC_ACQUIRE, "agent");
            asm volatile("s_waitcnt vmcnt(0)" ::: "memory");
        }
    }
    __syncthreads();
}


constexpr int LDS_BYTES = 147456;
constexpr int MISC_OFF = 147456 - 256;

DI void p0_mod(const int wv, KP p, int item, char* smem) {
    const int l = item / 96, cb = item % 96;
    const int tid = opaque_tid(wv);
    float* s_l = (float*)smem;
    float* red = s_l + 9 * 1024;
    __syncthreads();
    for (int i = tid; i < 9 * 1024; i += 512) {
        int bb = i >> 10, k = i & 1023;
        float v = bb < 8 ? p->c[bb * 1024 + k] : p->c_ctx[k];
        s_l[i] = v / (1.f + expf(-v));
    }
    __syncthreads();
    const int col = cb * 64 + (tid & 63), kg = tid >> 6;
    float acc[9];
#pragma unroll
    for (int bb = 0; bb < 9; ++bb) acc[bb] = 0.f;
    const float* wp = p->w_mod + (size_t)l * 1024 * 6144 + col;
#pragma unroll 8
    for (int k = kg * 128; k < kg * 128 + 128; ++k) {
        float wv_ = wp[(size_t)k * 6144];
#pragma unroll
        for (int bb = 0; bb < 9; ++bb) acc[bb] += s_l[bb * 1024 + k] * wv_;
    }
#pragma unroll
    for (int bb = 0; bb < 9; ++bb) red[(kg * 9 + bb) * 64 + (tid & 63)] = acc[bb];
    __syncthreads();
    for (int i = tid; i < 9 * 64; i += 512) {
        int bb = i >> 6, cc = i & 63;
        int cg_ = cb * 64 + cc;
        float v = 0.f;
#pragma unroll
        for (int q = 0; q < 8; ++q) v += red[(q * 9 + bb) * 64 + cc];
        v += p->b_mod[l * 6144 + cg_];
        int sec = cg_ >> 10, k = cg_ & 1023;
        if (sec == 1) v = p->norm_gain[(l * 2 + 0) * 1024 + k] * (1.f + v);
        if (sec == 4) v = p->norm_gain[(l * 2 + 1) * 1024 + k] * (1.f + v);
        WS{p->ws}.modv()[((size_t)(l * 6 + sec) * 9 + bb) * 1024 + k] = v;
    }
}

DI void p0_convert(const int wv, KP p, int mode, int l, int kt, int nt, char* smem) {
    float* tile = (float*)smem;
    const int tid = opaque_tid(wv);
    const float* src;
    unsigned short* dst;
    int srcN, K;
    if (mode == 0) { src = p->w_in + (size_t)l * 1024 * INC; srcN = INC; K = 1024; dst = WS{p->ws}.WtIn() + (size_t)l * NP * 1024; }
    else if (mode == 1) { src = p->w_out + (size_t)l * 1024 * 1024; srcN = 1024; K = 1024; dst = WS{p->ws}.WtOut() + (size_t)l * 1024 * 1024; }
    else if (mode == 2) { src = p->w_ffn_in + (size_t)l * 1024 * FFN2; srcN = FFN2; K = 1024; dst = WS{p->ws}.WtF1() + (size_t)l * FFN2 * 1024; }
    else { src = p->w_ffn_out + (size_t)l * FFN * 1024; srcN = 1024; K = FFN; dst = WS{p->ws}.WtF2() + (size_t)l * 1024 * FFN; }
    __syncthreads();
    {
        const int c4 = (tid & 15) * 4;
        const int n = nt * 64 + c4;
        int sc;
        if (mode == 0) {
            int nn = n;
            if (n >= C_AQ && n < C_AV) { const int q = n & 31; nn = (n & ~31) + 16 * ((q >> 2) & 1) + 4 * (q >> 3) + (q & 3); }
            sc = nn < 1024 ? nn : (nn < 2304 ? nn + 16 : (nn < 2320 ? nn - 1280 : -1));
        }
        else if (mode == 2) { int pn_ = n >> 8, wi = n & 255; sc = pn_ * 128 + (wi & 127) + (wi >= 128 ? FFN : 0); }
        else sc = n;
#pragma unroll
        for (int i = 0; i < 2; ++i) {
            const int kk = (tid >> 4) + 32 * i;
            float4 v = make_float4(0.f, 0.f, 0.f, 0.f);
            if (sc >= 0) v = *(const float4*)(src + (size_t)(kt * 64 + kk) * srcN + sc);
            tile[kk * 65 + c4 + 0] = v.x; tile[kk * 65 + c4 + 1] = v.y; tile[kk * 65 + c4 + 2] = v.z; tile[kk * 65 + c4 + 3] = v.w;
        }
    }
    __syncthreads();
    {
        const int n = tid >> 3, k0 = (tid & 7) * 8;
        unsigned o[4];
#pragma unroll
        for (int q = 0; q < 4; ++q) o[q] = cvtpk(tile[(k0 + 2 * q) * 65 + n], tile[(k0 + 2 * q + 1) * 65 + n]);
        unsigned short* d = dst + (size_t)(nt * 64 + n) * K + kt * 64 + k0;
        *(uint4*)d = make_uint4(o[0], o[1], o[2], o[3]);
    }
}

DI void p0_fold(const int wv, KP p, int l, int kt, int nt, char* smem) {
    float* pwS = (float*)smem;
    float* woS = pwS + 64 * 65;
    const int tid = opaque_tid(wv), n = tid & 63, kg = tid >> 6;
    float acc[8];
#pragma unroll
    for (int i = 0; i < 8; ++i) acc[i] = 0.f;
    for (int jc = 0; jc < 4; ++jc) {
        __syncthreads();
        for (int i = tid; i < 64 * 64; i += 512) {
            int r = i >> 6, cc = i & 63;
            pwS[r * 65 + cc] = p->pw_w[(size_t)l * 65536 + (kt * 64 + r) * 256 + jc * 64 + cc];
            woS[r * 64 + cc] = p->w_out[(size_t)l * 1024 * 1024 + (size_t)(768 + jc * 64 + r) * 1024 + nt * 64 + cc];
        }
        __syncthreads();
        for (int j = 0; j < 64; ++j) {
            float wo = woS[j * 64 + n];
#pragma unroll
            for (int i = 0; i < 8; ++i) acc[i] += pwS[(kg * 8 + i) * 65 + j] * wo;
        }
    }
    unsigned o[4];
#pragma unroll
    for (int q = 0; q < 4; ++q) o[q] = cvtpk(acc[2 * q], acc[2 * q + 1]);
    unsigned short* d = WS{p->ws}.WtOut() + (size_t)l * 1024 * 1024 + (size_t)(nt * 64 + n) * 1024 + 768 + kt * 64 + kg * 8;
    *(uint4*)d = make_uint4(o[0], o[1], o[2], o[3]);
}

DI void p0_shw(const int wv, KP p, const int l, const bool second, const int nb, char* smem) {
    float* shs = (float*)smem;
    const int tid = opaque_tid(wv), lane = tid & 63, w = tid >> 6;
    const float* shsrc = WS{p->ws}.modv() + (size_t)((l * 6 + (second ? 3 : 0)) * 9) * 1024;
    const unsigned short* Wt = second ? WS{p->ws}.WtF1() + (size_t)l * FFN2 * 1024 : WS{p->ws}.WtIn() + (size_t)l * NP * 1024;
    float* dst = second ? WS{p->ws}.shW2() + (size_t)l * 9 * FFN2 : WS{p->ws}.shW1() + (size_t)l * 9 * NP;
    const int NN = second ? FFN2 : NP;
    __syncthreads();
    for (int i = tid; i < 9 * 1024; i += 512) shs[i] = shsrc[i];
    __syncthreads();
    for (int q = 0; q < 8; ++q) {
        const int n = nb * 64 + w * 8 + q;
        const unsigned short* wr = Wt + (size_t)n * 1024 + lane * 16;
        uint4 a = *(const uint4*)wr, b = *(const uint4*)(wr + 8);
        float wv_[16];
        wv_[0] = bflo(a.x); wv_[1] = bfhi(a.x); wv_[2] = bflo(a.y); wv_[3] = bfhi(a.y);
        wv_[4] = bflo(a.z); wv_[5] = bfhi(a.z); wv_[6] = bflo(a.w); wv_[7] = bfhi(a.w);
        wv_[8] = bflo(b.x); wv_[9] = bfhi(b.x); wv_[10] = bflo(b.y); wv_[11] = bfhi(b.y);
        wv_[12] = bflo(b.z); wv_[13] = bfhi(b.z); wv_[14] = bflo(b.w); wv_[15] = bfhi(b.w);
#pragma unroll
        for (int bb = 0; bb < 9; ++bb) {
            float s = 0.f;
#pragma unroll
            for (int e = 0; e < 16; ++e) s += wv_[e] * shs[bb * 1024 + lane * 16 + e];
#pragma unroll
            for (int o = 32; o >= 1; o >>= 1) s += SX(s, o);
            if (lane == 0) dst[(size_t)bb * NN + n] = s;
        }
    }
}

DI void prep_item(const int wv, KP p, const int kind, const int l, const int idx, char* smem) {
    if (kind == 0) p0_convert(wv, p, 0, l, idx / 40, idx % 40, smem);
    else if (kind == 1) p0_convert(wv, p, 1, l, idx / 16, idx % 16, smem);
    else if (kind == 2) p0_convert(wv, p, 2, l, idx / 88, idx % 88, smem);
    else if (kind == 3) p0_convert(wv, p, 3, l, idx / 16, idx % 16, smem);
    else if (kind == 4) p0_fold(wv, p, l, idx / 16, idx % 16, smem);
    else p0_shw(wv, p, l, kind == 6, idx, smem);
}
constexpr int N_K0 = 16 * 40, N_K1 = 12 * 16, N_K2 = 16 * 88, N_K3 = 44 * 16, N_K4 = 64, N_K5 = 40, N_K6 = 88;

DI void fill_tail(const int wv, KP p, const int list, const int nbusy, char* smem) {
    const int nb_ = (int)gridDim.x > nbusy + 32 ? nbusy : 0;
    const int c = (int)blockIdx.x - nb_;
    if (c < 0) return;
    const int stride = (int)gridDim.x - nb_;
    int total;
    if (list == 0) total = N_K1 + N_K4 + N_K2;
    else if (list == 1) total = N_K3 + N_K0 + N_K1 + N_K4 + N_K6;
    else if (list == 2) total = N_K2 + N_K3 + N_K5;
    else total = N_K6;
    for (int it = c; it < total; it += stride) {
        int i = it;
        if (list == 0) {
            if (i < N_K1) { prep_item(wv, p, 1, 0, i, smem); continue; }
            i -= N_K1;
            if (i < N_K4) { prep_item(wv, p, 4, 0, i, smem); continue; }
            i -= N_K4;
            prep_item(wv, p, 2, 0, i, smem);
        } else if (list == 1) {
            if (i < N_K3) { prep_item(wv, p, 3, 0, i, smem); continue; }
            i -= N_K3;
            if (i < N_K0) { prep_item(wv, p, 0, 1, i, smem); continue; }
            i -= N_K0;
            if (i < N_K1) { prep_item(wv, p, 1, 1, i, smem); continue; }
            i -= N_K1;
            if (i < N_K4) { prep_item(wv, p, 4, 1, i, smem); continue; }
            i -= N_K4;
            prep_item(wv, p, 6, 0, i, smem);
        } else if (list == 2) {
            if (i < N_K2) { prep_item(wv, p, 2, 1, i, smem); continue; }
            i -= N_K2;
            if (i < N_K3) { prep_item(wv, p, 3, 1, i, smem); continue; }
            i -= N_K3;
            prep_item(wv, p, 5, 1, i, smem);
        } else {
            prep_item(wv, p, 6, 1, i, smem);
        }
    }
    __syncthreads();
}

DI void phase0a(const int wv, KP p, char* smem) {
    const int N_MOD = 192;
    const int total = N_MOD + N_K0 + 1;
    for (int it = blockIdx.x; it < total; it += gridDim.x) {
        int i = it;
        if (i < N_MOD) { p0_mod(wv, p, i, smem); continue; }
        i -= N_MOD;
        if (i < N_K0) { prep_item(wv, p, 0, 0, i, smem); continue; }
        const int tid_m = opaque_tid(wv);
        for (int e = tid_m; e < 128 * 16; e += 512) {
            int pos = e >> 4, f = e & 15;
            float freq = powf(10000.f, -(float)f / 16.f);
            float ang = (float)pos * freq;
            WS{p->ws}.rope()[e * 2 + 0] = cosf(ang);
            WS{p->ws}.rope()[e * 2 + 1] = sinf(ang);
        }
    }
}

DI void phase0c(const int wv, KP p, char* smem) {
    const int tid = opaque_tid(wv), lane = tid & 63, w = tid >> 6;
    for (int it = blockIdx.x; it < N_K5; it += gridDim.x) p0_shw(wv, p, 0, false, it, smem);
    float* rq = WS{p->ws}.rowsq();
    for (int rb = blockIdx.x; rb < NTOK / 8; rb += gridDim.x) {
        const int r = rb * 8 + w;
        const int bb = r < NLAT ? (r >> 13) : 8;
        const float* xp = r < NLAT ? p->x + (size_t)r * 1024 : p->ctx + (size_t)(r - NLAT) * 1024;
        const float* Gv = WS{p->ws}.modv() + (size_t)((0 * 6 + 1) * 9 + bb) * 1024;
        float s = 0.f;
#pragma unroll
        for (int i = 0; i < 4; ++i) {
            const float4 v = *(const float4*)(xp + i * 256 + lane * 4);
            const float4 gq = *(const float4*)(Gv + i * 256 + lane * 4);
            s += v.x * v.x + v.y * v.y + v.z * v.z + v.w * v.w;
            uint2 o;
            o.x = cvtpk(v.x * gq.x, v.y * gq.y);
            o.y = cvtpk(v.z * gq.z, v.w * gq.w);
            *(uint2*)(WS{p->ws}.xg() + (size_t)r * 1024 + i * 256 + lane * 4) = o;
        }
#pragma unroll
        for (int o = 32; o >= 1; o >>= 1) s += SX(s, o);
        if (lane == 0) rq[r] = s;
    }
}

struct EpiInproj {
    static constexpr bool PERM = true, AFTER_DRAIN = false;
    char* ws; int l;
    DI void operator()(const f32x4 (&acc)[2][2][4][2], const Unit& u, int wr, int wc, int fr, int fq) const {
        asm volatile("" : "+v"(fr), "+v"(fq));
        asm volatile("" : "+s"(wr), "+s"(wc));
        const WS W{ws};
        const int pn = u.pn, r0 = u.pm * 256;
        const int bb = r0 < NLAT ? (r0 >> 13) : 8;
        const float* sh = W.shW1() + (size_t)(l * 9 + bb) * NP;
        const float* rq = W.rowsq() + (size_t)(l * 2) * NTOK + r0 + 64 * wr + fr;
        unsigned short* P = W.P();
        float rs[2][4];
#pragma unroll
        for (int ai = 0; ai < 2; ++ai)
#pragma unroll
            for (int m = 0; m < 4; ++m) rs[ai][m] = rq[128 * ai + 16 * m];
#pragma unroll
        for (int bj = 0; bj < 2; ++bj) {
            const int cb = 256 * pn + 128 * bj + 32 * wc + 8 * fq;
            const float4 s0 = *(const float4*)(sh + cb);
            const float4 s1 = *(const float4*)(sh + cb + 4);
            const bool is_aq = (pn == 4 || pn == 5), is_ak = (pn == 6 && bj == 0), is_av = (pn == 6 && bj == 1);
#pragma unroll
            for (int ai = 0; ai < 2; ++ai)
#pragma unroll
                for (int m = 0; m < 4; ++m) {
                    const int r = r0 + 128 * ai + 64 * wr + 16 * m + fr;
                    const float rstd = rsqrtf(rs[ai][m] * (1.f / 1024.f) + EPS);
                    float v0[4], v1[4];
                    v0[0] = rstd * acc[ai][bj][m][0][0] + s0.x; v0[1] = rstd * acc[ai][bj][m][0][1] + s0.y;
                    v0[2] = rstd * acc[ai][bj][m][0][2] + s0.z; v0[3] = rstd * acc[ai][bj][m][0][3] + s0.w;
                    v1[0] = rstd * acc[ai][bj][m][1][0] + s1.x; v1[1] = rstd * acc[ai][bj][m][1][1] + s1.y;
                    v1[2] = rstd * acc[ai][bj][m][1][2] + s1.z; v1[3] = rstd * acc[ai][bj][m][1][3] + s1.w;
                    if (pn == 9) {
                        if (bj == 0 && wc == 0 && fq < 2) {
                            *(float4*)(W.gates() + (size_t)r * 16 + 8 * fq) = make_float4(v0[0], v0[1], v0[2], v0[3]);
                            *(float4*)(W.gates() + (size_t)r * 16 + 8 * fq + 4) = make_float4(v1[0], v1[1], v1[2], v1[3]);
                        }
                        continue;
                    }
                    if (is_aq || is_ak) {
                        if (r < NLAT) {
                            const int t = r & (SEQ - 1);
                            const int pos = ((wc & 1) == 0) ? (t >> 6) : (t & 63);
                            const float4 cs0 = *(const float4*)(W.rope() + (size_t)(pos * 16 + 4 * fq) * 2);
                            const float4 cs1 = *(const float4*)(W.rope() + (size_t)(pos * 16 + 4 * fq) * 2 + 4);
                            const float cc[4] = {cs0.x, cs0.z, cs1.x, cs1.z};
                            const float sn[4] = {cs0.y, cs0.w, cs1.y, cs1.w};
#pragma unroll
                            for (int i = 0; i < 4; ++i) {
                                const float x1 = v0[i], x2 = v1[i];
                                v0[i] = x1 * cc[i] - x2 * sn[i];
                                v1[i] = x2 * cc[i] + x1 * sn[i];
                            }
                        }
                        if (is_aq) {
#pragma unroll
                            for (int i = 0; i < 4; ++i) { v0[i] *= 0.125f * 1.44269504089f; v1[i] *= 0.125f * 1.44269504089f; }
                        }
                        const int c32 = 256 * pn + 128 * bj + 32 * wc;
                        uint2 o;
                        o.x = cvtpk(v0[0], v0[1]); o.y = cvtpk(v0[2], v0[3]);
                        *(uint2*)(P + (size_t)r * PSTR + c32 + 4 * fq) = o;
                        o.x = cvtpk(v1[0], v1[1]); o.y = cvtpk(v1[2], v1[3]);
                        *(uint2*)(P + (size_t)r * PSTR + c32 + 16 + 4 * fq) = o;
                        continue;
                    }
                    if (pn == 1) {
#pragma unroll
                        for (int i = 0; i < 4; ++i) { v0[i] *= 0.125f; v1[i] *= 0.125f; }
                    }
                    if (!(pn == 2 || is_av))
                        *(uint4*)(P + (size_t)r * PSTR + cb) = make_uint4(cvtpk(v0[0], v0[1]), cvtpk(v0[2], v0[3]), cvtpk(v1[0], v1[1]), cvtpk(v1[2], v1[3]));
                    if (pn == 1 || pn == 2 || is_av) {
                        unsigned short* T = pn == 1 ? W.MKT() : (pn == 2 ? W.MVT() : W.AVT());
                        const int nb2 = cb - (pn == 1 ? C_MK : (pn == 2 ? C_MV : C_AV));
#pragma unroll
                        for (int i = 0; i < 4; ++i) {
                            T[(size_t)(nb2 + i) * NTOK + r] = (unsigned short)(cvtpk(v0[i], 0.f) & 0xffffu);
                            T[(size_t)(nb2 + 4 + i) * NTOK + r] = (unsigned short)(cvtpk(v1[i], 0.f) & 0xffffu);
                        }
                    }
                }
        }
    }
};

struct EpiResid {
    static constexpr bool PERM = false, AFTER_DRAIN = true;
    const float* xold_lat; const float* xold_ctx; float* xnew_lat; float* xnew_ctx;
    const float* gate;
    const float* Gnext;
    unsigned short* xg;
    float* rsq;
    DI void operator()(const f32x4 (&acc)[2][2][4][2], const Unit& u, int wr, int wc, int fr, int fq) const {}
    DI void fused(f32x4 (&acc)[2][2][4][2], const Unit& u, int wr, int wc, int fr, int fq, LAS unsigned char* lds, int wid, int lane) const {
        asm volatile("" : "+v"(fr), "+v"(fq), "+v"(lane));
        asm volatile("" : "+s"(wr), "+s"(wc), "+s"(wid));
        const int pn = u.pn, r0 = u.pm * 256;
        const int bb = r0 < NLAT ? (r0 >> 13) : 8;
        const float* xo_b = r0 < NLAT ? xold_lat + (size_t)r0 * 1024 : xold_ctx + (size_t)(r0 - NLAT) * 1024;
        float* xn_b = r0 < NLAT ? xnew_lat + (size_t)r0 * 1024 : xnew_ctx + (size_t)(r0 - NLAT) * 1024;
        const int c = 256 * pn + 4 * lane;
        const float4 g4 = *(const float4*)(gate + (size_t)bb * 1024 + c);
        float4 q4 = make_float4(0.f, 0.f, 0.f, 0.f);
        if (Gnext) q4 = *(const float4*)(Gnext + (size_t)bb * 1024 + c);
#pragma unroll
        for (int ai = 0; ai < 2; ++ai) {
            float4 xo[16];
#pragma unroll
            for (int rr = 0; rr < 8; ++rr) xo[rr] = *(const float4*)(xo_b + (size_t)(128 * ai + wid * 16 + rr) * 1024 + c);
            __builtin_amdgcn_sched_barrier(0);
#pragma unroll
            for (int m = 0; m < 4; ++m)
#pragma unroll
                for (int bj = 0; bj < 2; ++bj)
#pragma unroll
                    for (int n = 0; n < 2; ++n) {
                        const int row = 64 * wr + 16 * m + fr;
                        const int ch = 32 * bj + 8 * wc + 4 * n + fq;
                        *(LAS f32x4*)(lds + row * 1024 + ((ch ^ (row & 15)) << 4)) = acc[ai][bj][m][n];
                    }
            LDS_BARRIER();
#pragma unroll
            for (int rr = 8; rr < 16; ++rr) xo[rr] = *(const float4*)(xo_b + (size_t)(128 * ai + wid * 16 + rr) * 1024 + c);
            __builtin_amdgcn_sched_barrier(0);
            float s[16];
#pragma unroll
            for (int rr = 0; rr < 16; ++rr) {
                if (rr == 8) __builtin_amdgcn_sched_barrier(0);
                const int row = wid * 16 + rr;
                const f32x4 a4 = *(const LAS f32x4*)(lds + row * 1024 + ((lane ^ (row & 15)) << 4));
                const int rl = 128 * ai + row;
                float4 o;
                o.x = xo[rr].x + g4.x * a4[0];
                o.y = xo[rr].y + g4.y * a4[1];
                o.z = xo[rr].z + g4.z * a4[2];
                o.w = xo[rr].w + g4.w * a4[3];
                *(float4*)(xn_b + (size_t)rl * 1024 + c) = o;
                if (Gnext) {
                    uint2 pk;
                    pk.x = cvtpk(o.x * q4.x, o.y * q4.y);
                    pk.y = cvtpk(o.z * q4.z, o.w * q4.w);
                    *(uint2*)(xg + (size_t)(r0 + rl) * 1024 + c) = pk;
                }
                s[rr] = o.x * o.x + o.y * o.y + o.z * o.z + o.w * o.w;
            }
            if (rsq) {
                const bool b5 = lane & 32, b4 = lane & 16, b3 = lane & 8, b2 = lane & 4;
                float t[8], u2[4], v2[2];
#pragma unroll
                for (int j = 0; j < 8; ++j) { const float snd = b5 ? s[j] : s[j + 8]; const float kp = b5 ? s[j + 8] : s[j]; t[j] = kp + SX(snd, 32); }
#pragma unroll
                for (int j = 0; j < 4; ++j) { const float snd = b4 ? t[j] : t[j + 4]; const float kp = b4 ? t[j + 4] : t[j]; u2[j] = kp + SX(snd, 16); }
#pragma unroll
                for (int j = 0; j < 2; ++j) { const float snd = b3 ? u2[j] : u2[j + 2]; const float kp = b3 ? u2[j + 2] : u2[j]; v2[j] = kp + SX(snd, 8); }
                float tot;
                { const float snd = b2 ? v2[0] : v2[1]; const float kp = b2 ? v2[1] : v2[0]; tot = kp + SX(snd, 4); }
                tot += SX(tot, 2);
                tot += SX(tot, 1);
                const int rrow = (b5 ? 8 : 0) + (b4 ? 4 : 0) + (b3 ? 2 : 0) + (b2 ? 1 : 0);
                if ((lane & 3) == 0) atomicAdd(rsq + r0 + 128 * ai + wid * 16 + rrow, tot);
            }
            LDS_BARRIER();
        }
    }
};

struct EpiFfnin {
    static constexpr bool PERM = true, AFTER_DRAIN = false;
    char* ws; int l;
    DI void operator()(const f32x4 (&acc)[2][2][4][2], const Unit& u, int wr, int wc, int fr, int fq) const {
        asm volatile("" : "+v"(fr), "+v"(fq));
        asm volatile("" : "+s"(wr), "+s"(wc));
        const WS W{ws};
        const int pn = u.pn, r0 = u.pm * 256;
        const int bb = r0 < NLAT ? (r0 >> 13) : 8;
        const float* sh = W.shW2() + (size_t)(l * 9 + bb) * FFN2 + 256 * pn + 32 * wc + 8 * fq;
        const float* rq = W.rowsq() + (size_t)(l * 2 + 1) * NTOK + r0 + 64 * wr + fr;
        unsigned short* hid = W.hid() + (size_t)(r0 + 64 * wr + fr) * FFN + 128 * pn + 32 * wc + 8 * fq;
        float rs[2][4];
#pragma unroll
        for (int ai = 0; ai < 2; ++ai)
#pragma unroll
            for (int m = 0; m < 4; ++m) rs[ai][m] = rq[128 * ai + 16 * m];
        const float4 sg0 = *(const float4*)(sh), sg1 = *(const float4*)(sh + 4);
        const float4 su0 = *(const float4*)(sh + 128), su1 = *(const float4*)(sh + 132);
        const float sg[8] = {sg0.x, sg0.y, sg0.z, sg0.w, sg1.x, sg1.y, sg1.z, sg1.w};
        const float su[8] = {su0.x, su0.y, su0.z, su0.w, su1.x, su1.y, su1.z, su1.w};
#pragma unroll
        for (int ai = 0; ai < 2; ++ai)
#pragma unroll
            for (int m = 0; m < 4; ++m) {
                const float rstd = rsqrtf(rs[ai][m] * (1.f / 1024.f) + EPS);
                float h[8];
#pragma unroll
                for (int n = 0; n < 2; ++n)
#pragma unroll
                    for (int i = 0; i < 4; ++i) {
                        const float gg = rstd * acc[ai][0][m][n][i] + sg[4 * n + i];
                        const float uu = rstd * acc[ai][1][m][n][i] + su[4 * n + i];
                        h[4 * n + i] = silu_f(gg) * uu;
                    }
                *(uint4*)(hid + (size_t)(128 * ai + 16 * m) * FFN) = make_uint4(cvtpk(h[0], h[1]), cvtpk(h[2], h[3]), cvtpk(h[4], h[5]), cvtpk(h[6], h[7]));
            }
    }
};

struct OneUnit {
    Unit u;
    DI bool next(int i, Unit& o) const { if (i != 0) return false; o = u; return true; }
    DI void a_ready(const Unit&) const {}
    DI void done(const Unit&) const {}
};
template <class Epi>
DI void run_gemm(char* smem, const unsigned short* A, const unsigned short* Bt, int M, int N, int K, const Epi& E) {
    pg8::Gemm g;
    g.A = A; g.Bt = Bt; g.M = M; g.N = N; g.K = K;
    pg8::StaticOrder S;
    S.init(M, N, (int)gridDim.x, (int)blockIdx.x);
    __syncthreads();
    if constexpr (Epi::AFTER_DRAIN) {
        for (int i = 0;; ++i) {
            OneUnit O;
            if (!S.next(i, O.u)) break;
            pg8::gemm_phase<Epi, OneUnit, false>((LAS unsigned char*)smem, g, O, E, nullptr);
            LDS_BARRIER();
        }
    } else {
        pg8::gemm_phase<Epi, pg8::StaticOrder, false>((LAS unsigned char*)smem, g, S, E, nullptr);
    }
    __syncthreads();
}

DI float scan_sum(float v, int lane, int dir) {
#pragma unroll
    for (int d = 1; d < 64; d <<= 1) {
        float o = shfl_i(v, dir ? lane + d : lane - d);
        bool ok = dir ? (lane + d < 64) : (lane >= d);
        if (ok) v += o;
    }
    return v;
}
DI float scan_max(float v, int lane, int dir) {
#pragma unroll
    for (int d = 1; d < 64; d <<= 1) {
        float o = shfl_i(v, dir ? lane + d : lane - d);
        bool ok = dir ? (lane + d < 64) : (lane >= d);
        if (ok) v = fmaxf(v, o);
    }
    return v;
}


DI void mlstm_chain(const int wv, KP p, const int l_, const int chain, char* smem) {
    const int l = opaque_s(l_);
    const int tid = opaque_tid(wv), lane = tid & 63, w = tid >> 6, g = lane >> 5, lr = lane & 31;
    const int w4 = w & 3;
    const int tb = w4 >> 1, eb = w4 & 1;
    const bool roleA = w < 4;
    const int dir = chain & 1, head = (chain >> 1) & 3, b = chain >> 3;
    char* T = smem;
    char* Cs = smem + 65536;
    float* n_s = (float*)(smem + 81920);
    float* wgw = (float*)(smem + 82432) + w4 * 64;
    float* sc_a = (float*)(smem + 83968);
    float* sc_pm = sc_a + 8 * 64;
    float* sc_bc = sc_pm + 8 * 64;
    float* sc_be = sc_bc + 8 * 64;
    float* sc_pa = sc_be + 8;
    const int lrow = tid >> 3, lch = tid & 7;
    const WS W{p->ws};
    const float bias_i = p->gate_bias[l * 16 + dir * 8 + head];
    const float bias_f = p->gate_bias[l * 16 + dir * 8 + 4 + head];
#define CHAIN_ROWBASE(step_) ((step_) < 4 ? (NLAT + b * CTXL + (dir ? 3 - (step_) : (step_)) * 64) : (b * SEQ + (dir ? 127 - ((step_) - 4) : (step_) - 4) * 64))
#define CHAIN_PREFETCHA(step_)                                                                              \
    {                                                                                                      \
        const int pr0 = CHAIN_ROWBASE(step_);                                                              \
        const unsigned short* pq = W.P() + (size_t)(pr0 + lrow) * PSTR + head * 64 + lch * 8;              \
        rqA = *(const uint4*)(pq + C_MQ);                                                                  \
        rkA = *(const uint4*)(pq + C_MK);                                                                  \
        const size_t to = (size_t)(head * 64 + lrow) * NTOK + pr0 + lch * 8;                               \
        rktA = *(const uint4*)(W.MKT() + to);                                                              \
        rvtA = *(const uint4*)(W.MVT() + to);                                                              \
    }
#define CHAIN_PREFETCHB(step_)                                                                              \
    {                                                                                                      \
        const int pr0 = CHAIN_ROWBASE(step_);                                                              \
        const unsigned short* pq = W.P() + (size_t)(pr0 + lrow) * PSTR + head * 64 + lch * 8;              \
        rqB = *(const uint4*)(pq + C_MQ);                                                                  \
        rkB = *(const uint4*)(pq + C_MK);                                                                  \
        const size_t to = (size_t)(head * 64 + lrow) * NTOK + pr0 + lch * 8;                               \
        rktB = *(const uint4*)(W.MKT() + to);                                                              \
        rvtB = *(const uint4*)(W.MVT() + to);                                                              \
    }
#define CHAIN_TILE_STOREA(buf_)                                                                             \
    {                                                                                                      \
        char* tb_ = T + (buf_) * 32768 + lds_off(lrow, lch);                                               \
        *(uint4*)(tb_) = rqA;                                                                              \
        *(uint4*)(tb_ + 8192) = rkA;                                                                       \
        *(uint4*)(tb_ + 16384) = rktA;                                                                     \
        *(uint4*)(tb_ + 24576) = rvtA;                                                                     \
    }
#define CHAIN_TILE_STOREB(buf_)                                                                             \
    {                                                                                                      \
        char* tb_ = T + (buf_) * 32768 + lds_off(lrow, lch);                                               \
        *(uint4*)(tb_) = rqB;                                                                              \
        *(uint4*)(tb_ + 8192) = rkB;                                                                       \
        *(uint4*)(tb_ + 16384) = rktB;                                                                     \
        *(uint4*)(tb_ + 24576) = rvtB;                                                                     \
    }
#define CHAIN_GLOAD(c_)                                                                                    \
    {                                                                                                      \
        const int pr0 = CHAIN_ROWBASE(c_);                                                                 \
        g_i = W.gates()[(size_t)(pr0 + lane) * 16 + dir * 8 + head];                                       \
        g_f = W.gates()[(size_t)(pr0 + lane) * 16 + dir * 8 + 4 + head];                                   \
    }
#define CHAIN_SCAN(c_)                                                                                     \
    {                                                                                                      \
        const int sl = (c_) & 7;                                                                           \
        const float li = g_i + bias_i;                                                                     \
        const float xfg = g_f + bias_f;                                                                    \
        const float lf = fminf(xfg, 0.f) - log1pf(expf(-fabsf(xfg)));                                      \
        const float bc = scan_sum(lf, lane, dir);                                                          \
        const float a = li - bc;                                                                           \
        const float pm = scan_max(a, lane, dir);                                                           \
        sc_a[sl * 64 + lane] = a;                                                                          \
        sc_pm[sl * 64 + lane] = pm;                                                                        \
        sc_bc[sl * 64 + lane] = bc;                                                                        \
        if (lane == (dir ? 0 : 63)) { sc_be[sl] = bc; sc_pa[sl] = pm; }                                    \
    }
    float g_i = 0.f, g_f = 0.f;
    if (roleA) __builtin_amdgcn_s_setprio(3);
    uint4 rqA, rkA, rktA, rvtA, rqB, rkB, rktB, rvtB;
    __syncthreads();
    { unsigned z0 = 0u; asm volatile("" : "+v"(z0)); *(uint4*)(Cs + tid * 16) = make_uint4(z0, z0, z0, z0); }
    if (tid < 128) n_s[tid] = 0.f;
    CHAIN_PREFETCHB(0);
    if (!roleA) {
        CHAIN_GLOAD(w4);
        CHAIN_SCAN(w4);
        CHAIN_GLOAD(4 + w4);
    }
    CHAIN_TILE_STOREB(0);
    CHAIN_PREFETCHA(1);
    CHAIN_PREFETCHB(2);
    f32x16 CT;
#pragma unroll
    for (int r = 0; r < 16; ++r) CT[r] = 0.f;
    float m = 0.f;
    __syncthreads();
    for (int step0 = 0; step0 < 132; step0 += 2) {
        {
            const int step = step0;
        const int cur = step & 1, nxt = cur ^ 1;
        const int j = step & 7;
        const int r0 = CHAIN_ROWBASE(step);
        if (step + 1 < 132) CHAIN_TILE_STOREA(nxt);
        if (step + 3 < 132) CHAIN_PREFETCHA(step + 3);
        const char* Qs = T + cur * 32768;
        const char* Ks = Qs + 8192;
        const char* KTs = Qs + 16384;
        const char* VTs = Qs + 24576;
        const float* a_s = sc_a + j * 64;
        const float b_end = sc_be[j];
        const float pmall = sc_pa[j];
        const float M = fmaxf(m, pmall);
        const float decay = __expf(m - M);
        const float m_new = b_end + M;
        const int tl = tb * 32 + lr;
        if (roleA) {
            const float mm_t = fmaxf(m, sc_pm[j * 64 + tl]);
            const float bc_t = sc_bc[j * 64 + tl];
            const float w_t = __expf(m - mm_t);
            const float einv_t = __expf(-(bc_t + mm_t));
            const int us = dir ? -1 : 1;
            int xq = (tl - 4 * g) * us;
            asm volatile("" : "+v"(xq));
            bf16x8 qf[4], kf0[4], kf1[4], cf[4];
#pragma unroll
            for (int ks = 0; ks < 4; ++ks) {
                qf[ks] = lds_frag(Qs, tl, ks * 2 + g);
                kf0[ks] = lds_frag(Ks, lr, ks * 2 + g);
                kf1[ks] = lds_frag(Ks, 32 + lr, ks * 2 + g);
                cf[ks] = lds_frag(Cs + cur * 8192, eb * 32 + lr, ks * 2 + g);
            }
            __builtin_amdgcn_sched_barrier(0);
            f32x16 sT[2], itv;
#pragma unroll
            for (int r = 0; r < 16; ++r) { sT[0][r] = 0.f; sT[1][r] = 0.f; itv[r] = 0.f; }
#pragma unroll
            for (int ks = 0; ks < 4; ++ks) {
                sT[0] = MFMA(kf0[ks], qf[ks], sT[0]);
                sT[1] = MFMA(kf1[ks], qf[ks], sT[1]);
                itv = MFMA(cf[ks], qf[ks], itv);
            }
            __builtin_amdgcn_sched_barrier(0);
            float qn = 0.f;
            {
                const float* ncur = n_s + cur * 64;
#pragma unroll
                for (int ks = 0; ks < 4; ++ks) {
                    const float4 n0v = *(const float4*)(ncur + ks * 16 + g * 8);
                    const float4 n1v = *(const float4*)(ncur + ks * 16 + g * 8 + 4);
                    qn += bf2f(qf[ks][0]) * n0v.x + bf2f(qf[ks][1]) * n0v.y + bf2f(qf[ks][2]) * n0v.z + bf2f(qf[ks][3]) * n0v.w;
                    qn += bf2f(qf[ks][4]) * n1v.x + bf2f(qf[ks][5]) * n1v.y + bf2f(qf[ks][6]) * n1v.z + bf2f(qf[ks][7]) * n1v.w;
                }
                qn += SX(qn, 32);
            }
            float cs = 0.f;
            f32x16 num;
            uint2 vta[4], vtb[4];
#pragma unroll
            for (int ksl = 0; ksl < 4; ++ksl) {
                vta[ksl] = *(const uint2*)(VTs + lds_off8(eb * 32 + lr, ksl * 16 + 4 * g));
                vtb[ksl] = *(const uint2*)(VTs + lds_off8(eb * 32 + lr, ksl * 16 + 8 + 4 * g));
            }
#pragma unroll
            for (int r = 0; r < 16; ++r) num[r] = itv[r] * w_t;
#pragma unroll
            for (int sb = 0; sb < 2; ++sb) {
#pragma unroll
                for (int hh = 0; hh < 2; ++hh) {
                    uint4 pu;
                    {
                        const int s0 = sb * 32 + 16 * hh + 4 * g;
                        const float4 av = *(const float4*)(a_s + s0);
                        const float4 bv = *(const float4*)(a_s + s0 + 8);
                        const int rb = 8 * hh;
                        const float p0 = sT[sb][rb + 0] * __expf(((sb * 32 + 16 * hh + 0) * us <= xq) ? (av.x - mm_t) : -1.0e30f);
                        const float p1 = sT[sb][rb + 1] * __expf(((sb * 32 + 16 * hh + 1) * us <= xq) ? (av.y - mm_t) : -1.0e30f);
                        const float p2 = sT[sb][rb + 2] * __expf(((sb * 32 + 16 * hh + 2) * us <= xq) ? (av.z - mm_t) : -1.0e30f);
                        const float p3 = sT[sb][rb + 3] * __expf(((sb * 32 + 16 * hh + 3) * us <= xq) ? (av.w - mm_t) : -1.0e30f);
                        const float p4 = sT[sb][rb + 4] * __expf(((sb * 32 + 16 * hh + 8) * us <= xq) ? (bv.x - mm_t) : -1.0e30f);
                        const float p5 = sT[sb][rb + 5] * __expf(((sb * 32 + 16 * hh + 9) * us <= xq) ? (bv.y - mm_t) : -1.0e30f);
                        const float p6 = sT[sb][rb + 6] * __expf(((sb * 32 + 16 * hh + 10) * us <= xq) ? (bv.z - mm_t) : -1.0e30f);
                        const float p7 = sT[sb][rb + 7] * __expf(((sb * 32 + 16 * hh + 11) * us <= xq) ? (bv.w - mm_t) : -1.0e30f);
                        cs += ((p0 + p1) + (p2 + p3)) + ((p4 + p5) + (p6 + p7));
                        pu = make_uint4(cvtpk(p0, p1), cvtpk(p2, p3), cvtpk(p4, p5), cvtpk(p6, p7));
                    }
                    const int ksl = sb * 2 + hh;
                    num = MFMA(u4_to_frag(make_uint4(vta[ksl].x, vta[ksl].y, vtb[ksl].x, vtb[ksl].y)), u4_to_frag(pu), num);
                }
            }
            cs += SX(cs, 32);
            {
                const float den = w_t * qn + cs;
                const float inv = __builtin_amdgcn_rcpf(fmaxf(fabsf(den), einv_t));
                unsigned short* hp = W.hdir() + (size_t)dir * NTOK * 256 + (size_t)(r0 + tl) * 256 + head * 64 + eb * 32 + 4 * g;
#pragma unroll
                for (int jj = 0; jj < 4; ++jj) {
                    uint2 o;
                    o.x = cvtpk(num[4 * jj] * inv, num[4 * jj + 1] * inv);
                    o.y = cvtpk(num[4 * jj + 2] * inv, num[4 * jj + 3] * inv);
                    *(uint2*)(hp + 8 * jj) = o;
                }
            }
        } else {
            if ((step & 3) == w4 && step + 4 < 132) {
                CHAIN_SCAN(step + 4);
                if (step + 8 < 132) CHAIN_GLOAD(step + 8);
            }
            wgw[lane] = __expf(a_s[lane] - M);
            asm volatile("s_waitcnt lgkmcnt(0)" ::: "memory");
#pragma unroll
            for (int r = 0; r < 16; ++r) CT[r] *= decay;
            float nsum = 0.f;
            bf16x8 kfs[4], vfs[4];
            float4 w0s[4], w1s[4];
#pragma unroll
            for (int ks = 0; ks < 4; ++ks) {
                kfs[ks] = lds_frag(KTs, tb * 32 + lr, ks * 2 + g);
                vfs[ks] = lds_frag(VTs, eb * 32 + lr, ks * 2 + g);
                w0s[ks] = *(const float4*)(wgw + ks * 16 + g * 8);
                w1s[ks] = *(const float4*)(wgw + ks * 16 + g * 8 + 4);
            }
            __builtin_amdgcn_sched_barrier(0);
#pragma unroll
            for (int ks = 0; ks < 4; ++ks) {
                const bf16x8 kf = kfs[ks];
                const float4 w0 = w0s[ks];
                const float4 w1 = w1s[ks];
                float e0 = bf2f(kf[0]) * w0.x, e1 = bf2f(kf[1]) * w0.y, e2 = bf2f(kf[2]) * w0.z, e3 = bf2f(kf[3]) * w0.w;
                float e4 = bf2f(kf[4]) * w1.x, e5 = bf2f(kf[5]) * w1.y, e6 = bf2f(kf[6]) * w1.z, e7 = bf2f(kf[7]) * w1.w;
                nsum += (e0 + e1) + (e2 + e3) + (e4 + e5) + (e6 + e7);
                const uint4 ku = make_uint4(cvtpk(e0, e1), cvtpk(e2, e3), cvtpk(e4, e5), cvtpk(e6, e7));
                CT = MFMA(u4_to_frag(ku), vfs[ks], CT);
            }
            nsum += SX(nsum, 32);
            if (eb == 0 && g == 0) n_s[nxt * 64 + tb * 32 + lr] = decay * n_s[cur * 64 + tb * 32 + lr] + nsum;
#pragma unroll
            for (int jj = 0; jj < 4; ++jj) {
                uint2 o;
                o.x = cvtpk(CT[4 * jj], CT[4 * jj + 1]);
                o.y = cvtpk(CT[4 * jj + 2], CT[4 * jj + 3]);
                *(uint2*)(Cs + nxt * 8192 + lds_off8(eb * 32 + lr, tb * 32 + 8 * jj + 4 * g)) = o;
            }
        }
        m = m_new;
        asm volatile("s_waitcnt lgkmcnt(0)" ::: "memory");
        __builtin_amdgcn_s_barrier();
        asm volatile("" ::: "memory");
        }
        {
            const int step = step0 + 1;
        const int cur = step & 1, nxt = cur ^ 1;
        const int j = step & 7;
        const int r0 = CHAIN_ROWBASE(step);
        if (step + 1 < 132) CHAIN_TILE_STOREB(nxt);
        if (step + 3 < 132) CHAIN_PREFETCHB(step + 3);
        const char* Qs = T + cur * 32768;
        const char* Ks = Qs + 8192;
        const char* KTs = Qs + 16384;
        const char* VTs = Qs + 24576;
        const float* a_s = sc_a + j * 64;
        const float b_end = sc_be[j];
        const float pmall = sc_pa[j];
        const float M = fmaxf(m, pmall);
        const float decay = __expf(m - M);
        const float m_new = b_end + M;
        const int tl = tb * 32 + lr;
        if (roleA) {
            const float mm_t = fmaxf(m, sc_pm[j * 64 + tl]);
            const float bc_t = sc_bc[j * 64 + tl];
            const float w_t = __expf(m - mm_t);
            const float einv_t = __expf(-(bc_t + mm_t));
            const int us = dir ? -1 : 1;
            int xq = (tl - 4 * g) * us;
            asm volatile("" : "+v"(xq));
            bf16x8 qf[4], kf0[4], kf1[4], cf[4];
#pragma unroll
            for (int ks = 0; ks < 4; ++ks) {
                qf[ks] = lds_frag(Qs, tl, ks * 2 + g);
                kf0[ks] = lds_frag(Ks, lr, ks * 2 + g);
                kf1[ks] = lds_frag(Ks, 32 + lr, ks * 2 + g);
                cf[ks] = lds_frag(Cs + cur * 8192, eb * 32 + lr, ks * 2 + g);
            }
            __builtin_amdgcn_sched_barrier(0);
            f32x16 sT[2], itv;
#pragma unroll
            for (int r = 0; r < 16; ++r) { sT[0][r] = 0.f; sT[1][r] = 0.f; itv[r] = 0.f; }
#pragma unroll
            for (int ks = 0; ks < 4; ++ks) {
                sT[0] = MFMA(kf0[ks], qf[ks], sT[0]);
                sT[1] = MFMA(kf1[ks], qf[ks], sT[1]);
                itv = MFMA(cf[ks], qf[ks], itv);
            }
            __builtin_amdgcn_sched_barrier(0);
            float qn = 0.f;
            {
                const float* ncur = n_s + cur * 64;
#pragma unroll
                for (int ks = 0; ks < 4; ++ks) {
                    const float4 n0v = *(const float4*)(ncur + ks * 16 + g * 8);
                    const float4 n1v = *(const float4*)(ncur + ks * 16 + g * 8 + 4);
                    qn += bf2f(qf[ks][0]) * n0v.x + bf2f(qf[ks][1]) * n0v.y + bf2f(qf[ks][2]) * n0v.z + bf2f(qf[ks][3]) * n0v.w;
                    qn += bf2f(qf[ks][4]) * n1v.x + bf2f(qf[ks][5]) * n1v.y + bf2f(qf[ks][6]) * n1v.z + bf2f(qf[ks][7]) * n1v.w;
                }
                qn += SX(qn, 32);
            }
            float cs = 0.f;
            f32x16 num;
            uint2 vta[4], vtb[4];
#pragma unroll
            for (int ksl = 0; ksl < 4; ++ksl) {
                vta[ksl] = *(const uint2*)(VTs + lds_off8(eb * 32 + lr, ksl * 16 + 4 * g));
                vtb[ksl] = *(const uint2*)(VTs + lds_off8(eb * 32 + lr, ksl * 16 + 8 + 4 * g));
            }
#pragma unroll
            for (int r = 0; r < 16; ++r) num[r] = itv[r] * w_t;
#pragma unroll
            for (int sb = 0; sb < 2; ++sb) {
#pragma unroll
                for (int hh = 0; hh < 2; ++hh) {
                    uint4 pu;
                    {
                        const int s0 = sb * 32 + 16 * hh + 4 * g;
                        const float4 av = *(const float4*)(a_s + s0);
                        const float4 bv = *(const float4*)(a_s + s0 + 8);
                        const int rb = 8 * hh;
                        const float p0 = sT[sb][rb + 0] * __expf(((sb * 32 + 16 * hh + 0) * us <= xq) ? (av.x - mm_t) : -1.0e30f);
                        const float p1 = sT[sb][rb + 1] * __expf(((sb * 32 + 16 * hh + 1) * us <= xq) ? (av.y - mm_t) : -1.0e30f);
                        const float p2 = sT[sb][rb + 2] * __expf(((sb * 32 + 16 * hh + 2) * us <= xq) ? (av.z - mm_t) : -1.0e30f);
                        const float p3 = sT[sb][rb + 3] * __expf(((sb * 32 + 16 * hh + 3) * us <= xq) ? (av.w - mm_t) : -1.0e30f);
                        const float p4 = sT[sb][rb + 4] * __expf(((sb * 32 + 16 * hh + 8) * us <= xq) ? (bv.x - mm_t) : -1.0e30f);
                        const float p5 = sT[sb][rb + 5] * __expf(((sb * 32 + 16 * hh + 9) * us <= xq) ? (bv.y - mm_t) : -1.0e30f);
                        const float p6 = sT[sb][rb + 6] * __expf(((sb * 32 + 16 * hh + 10) * us <= xq) ? (bv.z - mm_t) : -1.0e30f);
                        const float p7 = sT[sb][rb + 7] * __expf(((sb * 32 + 16 * hh + 11) * us <= xq) ? (bv.w - mm_t) : -1.0e30f);
                        cs += ((p0 + p1) + (p2 + p3)) + ((p4 + p5) + (p6 + p7));
                        pu = make_uint4(cvtpk(p0, p1), cvtpk(p2, p3), cvtpk(p4, p5), cvtpk(p6, p7));
                    }
                    const int ksl = sb * 2 + hh;
                    num = MFMA(u4_to_frag(make_uint4(vta[ksl].x, vta[ksl].y, vtb[ksl].x, vtb[ksl].y)), u4_to_frag(pu), num);
                }
            }
            cs += SX(cs, 32);
            {
                const float den = w_t * qn + cs;
                const float inv = __builtin_amdgcn_rcpf(fmaxf(fabsf(den), einv_t));
                unsigned short* hp = W.hdir() + (size_t)dir * NTOK * 256 + (size_t)(r0 + tl) * 256 + head * 64 + eb * 32 + 4 * g;
#pragma unroll
                for (int jj = 0; jj < 4; ++jj) {
                    uint2 o;
                    o.x = cvtpk(num[4 * jj] * inv, num[4 * jj + 1] * inv);
                    o.y = cvtpk(num[4 * jj + 2] * inv, num[4 * jj + 3] * inv);
                    *(uint2*)(hp + 8 * jj) = o;
                }
            }
        } else {
            if ((step & 3) == w4 && step + 4 < 132) {
                CHAIN_SCAN(step + 4);
                if (step + 8 < 132) CHAIN_GLOAD(step + 8);
            }
            wgw[lane] = __expf(a_s[lane] - M);
            asm volatile("s_waitcnt lgkmcnt(0)" ::: "memory");
#pragma unroll
            for (int r = 0; r < 16; ++r) CT[r] *= decay;
            float nsum = 0.f;
            bf16x8 kfs[4], vfs[4];
            float4 w0s[4], w1s[4];
#pragma unroll
            for (int ks = 0; ks < 4; ++ks) {
                kfs[ks] = lds_frag(KTs, tb * 32 + lr, ks * 2 + g);
                vfs[ks] = lds_frag(VTs, eb * 32 + lr, ks * 2 + g);
                w0s[ks] = *(const float4*)(wgw + ks * 16 + g * 8);
                w1s[ks] = *(const float4*)(wgw + ks * 16 + g * 8 + 4);
            }
            __builtin_amdgcn_sched_barrier(0);
#pragma unroll
            for (int ks = 0; ks < 4; ++ks) {
                const bf16x8 kf = kfs[ks];
                const float4 w0 = w0s[ks];
                const float4 w1 = w1s[ks];
                float e0 = bf2f(kf[0]) * w0.x, e1 = bf2f(kf[1]) * w0.y, e2 = bf2f(kf[2]) * w0.z, e3 = bf2f(kf[3]) * w0.w;
                float e4 = bf2f(kf[4]) * w1.x, e5 = bf2f(kf[5]) * w1.y, e6 = bf2f(kf[6]) * w1.z, e7 = bf2f(kf[7]) * w1.w;
                nsum += (e0 + e1) + (e2 + e3) + (e4 + e5) + (e6 + e7);
                const uint4 ku = make_uint4(cvtpk(e0, e1), cvtpk(e2, e3), cvtpk(e4, e5), cvtpk(e6, e7));
                CT = MFMA(u4_to_frag(ku), vfs[ks], CT);
            }
            nsum += SX(nsum, 32);
            if (eb == 0 && g == 0) n_s[nxt * 64 + tb * 32 + lr] = decay * n_s[cur * 64 + tb * 32 + lr] + nsum;
#pragma unroll
            for (int jj = 0; jj < 4; ++jj) {
                uint2 o;
                o.x = cvtpk(CT[4 * jj], CT[4 * jj + 1]);
                o.y = cvtpk(CT[4 * jj + 2], CT[4 * jj + 3]);
                *(uint2*)(Cs + nxt * 8192 + lds_off8(eb * 32 + lr, tb * 32 + 8 * jj + 4 * g)) = o;
            }
        }
        m = m_new;
        asm volatile("s_waitcnt lgkmcnt(0)" ::: "memory");
        __builtin_amdgcn_s_barrier();
        asm volatile("" ::: "memory");
        }
    }
    __builtin_amdgcn_s_setprio(0);
#undef CHAIN_ROWBASE
#undef CHAIN_PREFETCHA
#undef CHAIN_PREFETCHB
#undef CHAIN_TILE_STOREA
#undef CHAIN_TILE_STOREB
#undef CHAIN_SCAN
#undef CHAIN_GLOAD
}

DI void attn_item(const int wv, KP p, const int l_, const int item, const bool isctx, char* smem) {
    const int l = opaque_s(l_);
    const int tid = opaque_tid(wv), lane = tid & 63, w = tid >> 6, g = lane >> 5, lr = lane & 31;
    const int lrow = tid >> 3, lch = tid & 7;
    const WS W{p->ws};
    int b, kvh, q0, qrow0;
    if (!isctx) { b = item >> 8; kvh = (item >> 7) & 1; q0 = (item & 127) * 64; qrow0 = b * SEQ + q0; }
    else { b = item >> 3; kvh = (item >> 2) & 1; q0 = (item & 3) * 64; qrow0 = NLAT + b * CTXL + q0; }
    const int h = kvh * 4 + (w & 3);
    const int qb = w >> 2;
    char* KV = smem;
    char* Qw = smem + 32768 + w * 4096;
    LDS_BARRIER();
#pragma unroll
    for (int i = 0; i < 4; ++i) {
        const int row = (lane >> 3) + 8 * i, ch = lane & 7;
        *(uint4*)(Qw + lds_off(row, ch)) = *(const uint4*)(W.P() + (size_t)(qrow0 + qb * 32 + row) * PSTR + C_AQ + h * 64 + ch * 8);
    }
    const float sinkv = p->sink[l * 8 + h] * 1.44269504089f;
    float mrun = sinkv;
    float lrun = g == 0 ? 1.f : 0.f;
    f32x16 O0, O1;
#pragma unroll
    for (int r = 0; r < 16; ++r) { O0[r] = 0.f; O1[r] = 0.f; }
    int kstart = 0, ntl = 0;
    if (!isctx) {
        kstart = q0 - 128 < 0 ? 0 : q0 - 128;
        int kend = q0 + 192 > SEQ ? SEQ : q0 + 192;
        ntl = (kend - kstart) >> 6;
    }
    const unsigned short* kbase = W.P() + (size_t)lrow * PSTR + C_AK + kvh * 64 + lch * 8;
    const unsigned short* vbase = W.AVT() + (size_t)(kvh * 64 + lrow) * NTOK + lch * 8;
    uint4 kr0, vr0;
    const int ntot = ntl + 4;
    {
        const int krow_first = ntl > 0 ? b * SEQ + kstart : NLAT + b * CTXL;
        kr0 = *(const uint4*)(kbase + (size_t)krow_first * PSTR);
        vr0 = *(const uint4*)(vbase + krow_first);
    }
    *(uint4*)(KV + lds_off(lrow, lch)) = kr0;
    *(uint4*)(KV + 8192 + lds_off(lrow, lch)) = vr0;
    {
        const int krow_n = (1 < ntl) ? b * SEQ + kstart + 64 : NLAT + b * CTXL + (1 - ntl) * 64;
        kr0 = *(const uint4*)(kbase + (size_t)krow_n * PSTR);
        vr0 = *(const uint4*)(vbase + krow_n);
    }
    asm volatile("s_waitcnt lgkmcnt(0)" ::: "memory");
    __builtin_amdgcn_s_barrier();
    asm volatile("" ::: "memory");
    for (int tix = 0; tix < ntot; ++tix) {
        const bool local = tix < ntl;
        const int kpos0 = kstart + tix * 64;
        const char* Ks = KV + (tix & 1) * 16384;
        const char* VTs = Ks + 8192;
        if (tix + 1 < ntot) {
            char* kn = KV + ((tix + 1) & 1) * 16384;
            *(uint4*)(kn + lds_off(lrow, lch)) = kr0;
            *(uint4*)(kn + 8192 + lds_off(lrow, lch)) = vr0;
        }
        if (tix + 2 < ntot) {
            const int krow_n = (tix + 2 < ntl) ? b * SEQ + kpos0 + 128 : NLAT + b * CTXL + (tix + 2 - ntl) * 64;
            kr0 = *(const uint4*)(kbase + (size_t)krow_n * PSTR);
            vr0 = *(const uint4*)(vbase + krow_n);
        }
#pragma unroll
        for (int kb = 0; kb < 2; ++kb) {
            if (local) {
                const int k0b = kpos0 + kb * 32, q0b = q0 + qb * 32;
                if (k0b + 31 < q0b - 128 || k0b > q0b + 31 + 128) continue;
            }
            __builtin_amdgcn_sched_barrier(0);
            f32x16 s0;
#pragma unroll
            for (int r = 0; r < 16; ++r) s0[r] = 0.f;
            bf16x8 kfa[4], qfa[4];
            uint2 va0[2], va1[2], vb0[2], vb1[2];
#pragma unroll
            for (int ks = 0; ks < 4; ++ks) { kfa[ks] = lds_frag(Ks, kb * 32 + lr, ks * 2 + g); qfa[ks] = lds_frag(Qw, lr, ks * 2 + g); }
#pragma unroll
            for (int hh = 0; hh < 2; ++hh) {
                const int ksl = kb * 2 + hh;
                va0[hh] = *(const uint2*)(VTs + lds_off8(lr, ksl * 16 + 4 * g));
                va1[hh] = *(const uint2*)(VTs + lds_off8(lr, ksl * 16 + 8 + 4 * g));
                vb0[hh] = *(const uint2*)(VTs + lds_off8(32 + lr, ksl * 16 + 4 * g));
                vb1[hh] = *(const uint2*)(VTs + lds_off8(32 + lr, ksl * 16 + 8 + 4 * g));
            }
            __builtin_amdgcn_sched_barrier(0);
#pragma unroll
            for (int ks = 0; ks < 4; ++ks) s0 = MFMA(kfa[ks], qfa[ks], s0);
            if (local && (kpos0 < q0 - 64 || kpos0 > q0 + 64)) {
                const int dq = q0 + qb * 32 + lr - (kpos0 + kb * 32 + 4 * g);
#pragma unroll
                for (int r = 0; r < 16; ++r) {
                    const int d0 = dq - ((r & 3) + 8 * (r >> 2));
                    s0[r] = ((d0 <= 128) && (d0 >= -128)) ? s0[r] : -1.0e30f;
                }
            }
            float tmax = s0[0];
#pragma unroll
            for (int r = 1; r < 16; ++r) tmax = fmaxf(tmax, s0[r]);
            tmax = fmaxf(tmax, SX(tmax, 32));
            const float mnew = (tmax - mrun > 8.0f) ? tmax : mrun;
            const float alpha = __builtin_amdgcn_exp2f(mrun - mnew);
            float ls = 0.f;
#pragma unroll
            for (int r = 0; r < 16; ++r) {
                s0[r] = __builtin_amdgcn_exp2f(s0[r] - mnew);
                ls += s0[r];
            }
            mrun = mnew;
            lrun = lrun * alpha + ls;
            if (__any(alpha != 1.f)) {
#pragma unroll
                for (int r = 0; r < 16; ++r) { O0[r] *= alpha; O1[r] *= alpha; }
            }
#pragma unroll
            for (int hh = 0; hh < 2; ++hh) {
                const uint4 pu = make_uint4(cvtpk(s0[8 * hh + 0], s0[8 * hh + 1]), cvtpk(s0[8 * hh + 2], s0[8 * hh + 3]), cvtpk(s0[8 * hh + 4], s0[8 * hh + 5]), cvtpk(s0[8 * hh + 6], s0[8 * hh + 7]));
                const bf16x8 pf = u4_to_frag(pu);
                O0 = MFMA(u4_to_frag(make_uint4(va0[hh].x, va0[hh].y, va1[hh].x, va1[hh].y)), pf, O0);
                O1 = MFMA(u4_to_frag(make_uint4(vb0[hh].x, vb0[hh].y, vb1[hh].x, vb1[hh].y)), pf, O1);
            }
        }
        asm volatile("s_waitcnt lgkmcnt(0)" ::: "memory");
        __builtin_amdgcn_s_barrier();
        asm volatile("" ::: "memory");
    }
    {
        const float lt = lrun + SX(lrun, 32);
        const float inv = 1.f / lt;
        unsigned short* op = W.mix() + (size_t)(qrow0 + qb * 32 + lr) * 1024 + 256 + h * 64 + 4 * g;
#pragma unroll
        for (int j = 0; j < 4; ++j) {
            uint2 o;
            o.x = cvtpk(O0[4 * j] * inv, O0[4 * j + 1] * inv);
            o.y = cvtpk(O0[4 * j + 2] * inv, O0[4 * j + 3] * inv);
            *(uint2*)(op + 8 * j) = o;
            o.x = cvtpk(O1[4 * j] * inv, O1[4 * j + 1] * inv);
            o.y = cvtpk(O1[4 * j + 2] * inv, O1[4 * j + 3] * inv);
            *(uint2*)(op + 32 + 8 * j) = o;
        }
    }
}

DI void conv_item(const int wv, KP p, const int l_, const int item, const bool isctx, char* smem) {
    const int l = opaque_s(l_);
    const int tid = opaque_tid(wv), lane = tid & 63, w = tid >> 6;
    const int c = tid & 255, half = tid >> 8;
    const WS W{p->ws};
    int rowbase, L, t0;
    if (!isctx) { const int b = item >> 7; rowbase = b * SEQ; L = SEQ; t0 = (item & 127) * 64; }
    else { const int b = item >> 2; rowbase = NLAT + b * CTXL; L = CTXL; t0 = (item & 3) * 64; }
    float* ys = (float*)smem;
    LDS_BARRIER();
    for (int u = tid; u < 94 * 32; u += 512) {
        const int rr = u >> 5, c8 = (u & 31) * 8;
        const int t = t0 - 15 + rr;
        float y[8];
        if (t >= 0 && t < L) {
            const uint4 av = *(const uint4*)(W.P() + (size_t)(rowbase + t) * PSTR + C_CV + c8);
            const uint4 gv = *(const uint4*)(W.P() + (size_t)(rowbase + t) * PSTR + C_CV + 256 + c8);
            y[0] = bflo(av.x) * sigmoid_f(bflo(gv.x)); y[1] = bfhi(av.x) * sigmoid_f(bfhi(gv.x));
            y[2] = bflo(av.y) * sigmoid_f(bflo(gv.y)); y[3] = bfhi(av.y) * sigmoid_f(bfhi(gv.y));
            y[4] = bflo(av.z) * sigmoid_f(bflo(gv.z)); y[5] = bfhi(av.z) * sigmoid_f(bfhi(gv.z));
            y[6] = bflo(av.w) * sigmoid_f(bflo(gv.w)); y[7] = bfhi(av.w) * sigmoid_f(bfhi(gv.w));
        } else {
#pragma unroll
            for (int i = 0; i < 8; ++i) y[i] = 0.f;
        }
        *(float4*)(ys + rr * 256 + c8) = make_float4(y[0], y[1], y[2], y[3]);
        *(float4*)(ys + rr * 256 + c8 + 4) = make_float4(y[4], y[5], y[6], y[7]);
    }
    float wj[31];
#pragma unroll
    for (int j = 0; j < 31; ++j) wj[j] = p->dw_w[(size_t)l * 31 * 256 + j * 256 + c];
    const float bias = p->dw_b[l * 256 + c];
    LDS_BARRIER();
    float z[32];
#pragma unroll
    for (int t = 0; t < 32; ++t) z[t] = bias;
    const float* ysh = ys + half * 32 * 256 + c;
#pragma unroll
    for (int rr = 0; rr < 62; ++rr) {
        const float yv = ysh[rr * 256];
#pragma unroll
        for (int t = 0; t < 32; ++t) {
            const int j = rr - t;
            if (j >= 0 && j < 31) z[t] += yv * wj[j];
        }
    }
    LDS_BARRIER();
#pragma unroll
    for (int t = 0; t < 32; ++t) ys[(half * 32 + t) * 256 + c] = z[t];
    LDS_BARRIER();
    const float4 lg = *(const float4*)(p->ln_g + l * 256 + lane * 4);
    const float4 lb = *(const float4*)(p->ln_b + l * 256 + lane * 4);
#pragma unroll
    for (int q = 0; q < 8; ++q) {
        const int t = w * 8 + q;
        const float4 zv = *(const float4*)(ys + t * 256 + lane * 4);
        float s = zv.x + zv.y + zv.z + zv.w;
#pragma unroll
        for (int o = 32; o >= 1; o >>= 1) s += SX(s, o);
        const float mu = s * (1.f / 256.f);
        const float d0 = zv.x - mu, d1 = zv.y - mu, d2 = zv.z - mu, d3 = zv.w - mu;
        float v = d0 * d0 + d1 * d1 + d2 * d2 + d3 * d3;
#pragma unroll
        for (int o = 32; o >= 1; o >>= 1) v += SX(v, o);
        const float rstd = rsqrtf(v * (1.f / 256.f) + EPS);
        const float o0 = silu_f(d0 * rstd * lg.x + lb.x), o1 = silu_f(d1 * rstd * lg.y + lb.y);
        const float o2 = silu_f(d2 * rstd * lg.z + lb.z), o3 = silu_f(d3 * rstd * lg.w + lb.w);
        uint2 o;
        o.x = cvtpk(o0, o1);
        o.y = cvtpk(o2, o3);
        *(uint2*)(W.mix() + (size_t)(rowbase + t0 + t) * 1024 + 768 + lane * 4) = o;
    }
}

DI void phase_mixers(const int wv, KP p, const int l, char* smem) {
    const int n_chain = 64;
    const int n_al = NB * 2 * 128;
    const int n_ac = (l == 0) ? NB * 2 * 4 : 0;
    const int n_cl = NB * 128;
    const int n_cc = (l == 0) ? NB * 4 : 0;
    const int total = n_chain + n_al + n_ac + n_cl + n_cc;
    int* slot = (int*)(smem + MISC_OFF + 64);
    const bool t0 = opaque_tid(wv) == 0;
    int nxt_item = 0;
    if (t0) nxt_item = (int)atomicAdd(WS{p->ws}.ctr() + l, 1u);
    for (;;) {
        LDS_BARRIER();
        if (t0) *slot = nxt_item;
        LDS_BARRIER();
        int it = *slot;
        if (it >= total) break;
        if (it < n_chain) {
            mlstm_chain(wv, p, l, it, smem);
            if (t0) nxt_item = (int)atomicAdd(WS{p->ws}.ctr() + l, 1u);
            continue;
        }
        if (t0) nxt_item = (int)atomicAdd(WS{p->ws}.ctr() + l, 1u);
        it -= n_chain;
        if (it < n_al) { attn_item(wv, p, l, it, false, smem); continue; }
        it -= n_al;
        if (it < n_ac) { attn_item(wv, p, l, it, true, smem); continue; }
        it -= n_ac;
        if (it < n_cl) { conv_item(wv, p, l, it, false, smem); continue; }
        it -= n_cl;
        conv_item(wv, p, l, it, true, smem);
    }
}

DI void phase_mfinal(const int wv, KP p, const int l) {
    const int tid = opaque_tid(wv);
    const int lane = tid & 63;
    const WS W{p->ws};
    const int nrows = (l == 0) ? NTOK : NLAT;
    const int rsub = tid >> 5, c8 = (tid & 31) * 8;
    const float4 g0 = *(const float4*)(p->head_gain + l * 256 + c8);
    const float4 g1 = *(const float4*)(p->head_gain + l * 256 + c8 + 4);
    const float gg[8] = {g0.x, g0.y, g0.z, g0.w, g1.x, g1.y, g1.z, g1.w};
    for (int rb = blockIdx.x; rb < nrows / 16; rb += gridDim.x) {
        const int r = rb * 16 + rsub;
        const uint4 a = *(const uint4*)(W.hdir() + (size_t)r * 256 + c8);
        const uint4 b = *(const uint4*)(W.hdir() + (size_t)NTOK * 256 + (size_t)r * 256 + c8);
        const uint4 ov = *(const uint4*)(W.P() + (size_t)r * PSTR + C_MO + c8);
        float hv[8], o8[8];
        hv[0] = bflo(a.x) + bflo(b.x); hv[1] = bfhi(a.x) + bfhi(b.x);
        hv[2] = bflo(a.y) + bflo(b.y); hv[3] = bfhi(a.y) + bfhi(b.y);
        hv[4] = bflo(a.z) + bflo(b.z); hv[5] = bfhi(a.z) + bfhi(b.z);
        hv[6] = bflo(a.w) + bflo(b.w); hv[7] = bfhi(a.w) + bfhi(b.w);
        o8[0] = bflo(ov.x); o8[1] = bfhi(ov.x); o8[2] = bflo(ov.y); o8[3] = bfhi(ov.y);
        o8[4] = bflo(ov.z); o8[5] = bfhi(ov.z); o8[6] = bflo(ov.w); o8[7] = bfhi(ov.w);
        float s = 0.f;
#pragma unroll
        for (int i = 0; i < 8; ++i) s += hv[i] * hv[i];
        s += SX(s, 1);
        s += SX(s, 2);
        s += SX(s, 4);
        const float rstd = rsqrtf(s * (1.f / 64.f) + EPS);
        float y[8];
#pragma unroll
        for (int i = 0; i < 8; ++i) y[i] = hv[i] * rstd * gg[i] * sigmoid_f(o8[i]);
        *(uint4*)(W.mix() + (size_t)r * 1024 + c8) = make_uint4(cvtpk(y[0], y[1]), cvtpk(y[2], y[3]), cvtpk(y[4], y[5]), cvtpk(y[6], y[7]));
    }
}

DI void phase_final(const int wv, KP p) {
    const int tid = opaque_tid(wv), lane = tid & 63, w = tid >> 6;
    for (int rb = blockIdx.x; rb < NLAT / 8; rb += gridDim.x) {
        const int r = rb * 8 + w;
        float* xp = p->out + (size_t)r * 1024;
        float4 v[4];
        float s = 0.f;
#pragma unroll
        for (int i = 0; i < 4; ++i) {
            v[i] = *(const float4*)(xp + i * 256 + lane * 4);
            s += v[i].x * v[i].x + v[i].y * v[i].y + v[i].z * v[i].z + v[i].w * v[i].w;
        }
#pragma unroll
        for (int o = 32; o >= 1; o >>= 1) s += SX(s, o);
        const float rstd = rsqrtf(s * (1.f / 1024.f) + EPS);
#pragma unroll
        for (int i = 0; i < 4; ++i) {
            const float4 gn = *(const float4*)(p->final_gain + i * 256 + lane * 4);
            *(float4*)(xp + i * 256 + lane * 4) = make_float4(v[i].x * rstd * gn.x, v[i].y * rstd * gn.y, v[i].z * rstd * gn.z, v[i].w * rstd * gn.w);
        }
    }
}

__global__ void __launch_bounds__(512, 2) fwd_megakernel(Params p_unused) {
    extern __shared__ __attribute__((aligned(16))) char smem[];
    cg::grid_group grid = cg::this_grid();
    const int wv = __builtin_amdgcn_readfirstlane((int)(threadIdx.x >> 6));
    volatile LAS unsigned* misc = (volatile LAS unsigned*)((LAS char*)smem + MISC_OFF);
    if (threadIdx.x < 16) misc[threadIdx.x] = 0u;
    __syncthreads();
    const KP p0 = (KP)__builtin_amdgcn_kernarg_segment_ptr();
    (void)xcd_barrier_post(WS{p0->ws}.bar(), misc);
#define GRID_BAR() do { XcdBarrier bar_; bar_.bar = WS{opaque_kp(p0)->ws}.bar(); bar_.x = xb_xcc_id(); bar_.st = (volatile LAS unsigned*)((LAS char*)smem + MISC_OFF); xcd_barrier(bar_, opaque_tid(wv) == 0); } while (0)
    phase0a(wv, opaque_kp(p0), smem);
    if (p0->ws == nullptr) grid.sync();
    GRID_BAR();
    phase0c(wv, opaque_kp(p0), smem);
    GRID_BAR();
#pragma unroll 1
    for (int l = 0; l < 2; ++l) {
        const int M = (l == 0) ? NTOK : NLAT;
        {
            const KP p = opaque_kp(p0);
            const WS W{p->ws};
            EpiInproj E; E.ws = p->ws; E.l = l;
            run_gemm(smem, W.xg(), W.WtIn() + (size_t)l * NP * 1024, NTOK, NP, 1024, E);
            fill_tail(wv, p, l == 0 ? 0 : 3, (NTOK / 256) * (NP / 256) - 10 * 256, smem);
        }
        GRID_BAR();
        phase_mixers(wv, opaque_kp(p0), l, smem);
        GRID_BAR();
        phase_mfinal(wv, opaque_kp(p0), l);
        GRID_BAR();
        {
            const KP p = opaque_kp(p0);
            const WS W{p->ws};
            EpiResid E;
            E.xold_lat = (l == 0) ? p->x : p->out; E.xold_ctx = (l == 0) ? p->ctx : W.ctxa();
            E.xnew_lat = p->out; E.xnew_ctx = W.ctxa();
            E.gate = W.modv() + (size_t)((l * 6 + 2) * 9) * 1024;
            E.Gnext = W.modv() + (size_t)((l * 6 + 4) * 9) * 1024;
            E.xg = W.xg();
            E.rsq = W.rowsq() + (size_t)(l * 2 + 1) * NTOK;
            run_gemm(smem, W.mix(), W.WtOut() + (size_t)l * 1024 * 1024, M, 1024, 1024, E);
            if (l == 0) fill_tail(wv, p, 1, (NTOK / 256) * 4 - 4 * 256, smem);
        }
        GRID_BAR();
        {
            const KP p = opaque_kp(p0);
            const WS W{p->ws};
            EpiFfnin E; E.ws = p->ws; E.l = l;
            run_gemm(smem, W.xg(), W.WtF1() + (size_t)l * FFN2 * 1024, M, FFN2, 1024, E);
        }
        GRID_BAR();
        {
            const KP p = opaque_kp(p0);
            const WS W{p->ws};
            EpiResid E;
            E.xold_lat = p->out; E.xold_ctx = W.ctxa();
            E.xnew_lat = p->out; E.xnew_ctx = W.ctxa();
            E.gate = W.modv() + (size_t)((l * 6 + 5) * 9) * 1024;
            E.Gnext = (l == 0) ? W.modv() + (size_t)((1 * 6 + 1) * 9) * 1024 : nullptr;
            E.xg = W.xg();
            E.rsq = (l == 0) ? W.rowsq() + (size_t)2 * NTOK : nullptr;
            run_gemm(smem, W.hid(), W.WtF2() + (size_t)l * 1024 * FFN, M, 1024, FFN, E);
            if (l == 0) fill_tail(wv, p, 2, (NTOK / 256) * 4 - 4 * 256, smem);
        }
        GRID_BAR();
    }
    phase_final(wv, opaque_kp(p0));
}

extern "C" void kernel_launch(void* const* d_in, const int* in_sizes, int n_in, void* d_out, int out_size, void* d_ws,
                              size_t ws_size, hipStream_t stream) {
    static int grid_blocks = 0;
    if (!grid_blocks) {
        int dev = 0, cus = 0;
        (void)hipGetDevice(&dev);
        (void)hipDeviceGetAttribute(&cus, hipDeviceAttributeMultiprocessorCount, dev);
        if (hipFuncSetAttribute((const void*)fwd_megakernel, hipFuncAttributeMaxDynamicSharedMemorySize, LDS_BYTES) != hipSuccess)
            fprintf(stderr, "hipFuncSetAttribute(MaxDynamicSharedMemorySize) failed\n");
        int per_cu = 0;
        if (hipOccupancyMaxActiveBlocksPerMultiprocessor(&per_cu, (const void*)fwd_megakernel, 512, LDS_BYTES) != hipSuccess || per_cu < 1)
            fprintf(stderr, "occupancy query says %d blocks per CU\n", per_cu);
        (void)hipGetLastError();
        grid_blocks = cus > 0 ? cus : 256;
    }
    Params p{};
    p.x = (const float*)d_in[0]; p.c = (const float*)d_in[1]; p.ctx = (const float*)d_in[2]; p.c_ctx = (const float*)d_in[3];
    p.w_mod = (const float*)d_in[4]; p.b_mod = (const float*)d_in[5]; p.norm_gain = (const float*)d_in[6]; p.w_in = (const float*)d_in[7];
    p.gate_bias = (const float*)d_in[8]; p.head_gain = (const float*)d_in[9]; p.sink = (const float*)d_in[10];
    p.dw_w = (const float*)d_in[11]; p.dw_b = (const float*)d_in[12]; p.ln_g = (const float*)d_in[13]; p.ln_b = (const float*)d_in[14];
    p.pw_w = (const float*)d_in[15]; p.w_out = (const float*)d_in[16]; p.w_ffn_in = (const float*)d_in[17]; p.w_ffn_out = (const float*)d_in[18];
    p.final_gain = (const float*)d_in[19];
    p.out = (float*)d_out;
    p.ws = (char*)d_ws;
    if (O_END > ws_size) fprintf(stderr, "workspace too small: need %zu have %zu\n", (size_t)O_END, ws_size);
    (void)hipMemsetAsync((char*)d_ws + O_CTR, 0, (O_ROWSQ - O_CTR) + (size_t)5 * NTOK * 4, stream);
    void* args[] = {&p};
    hipError_t e = hipLaunchCooperativeKernel((void*)fwd_megakernel, dim3(grid_blocks), dim3(512), args, LDS_BYTES, stream);
    if (e != hipSuccess) fprintf(stderr, "cooperative launch failed: %s (grid %d)\n", hipGetErrorString(e), grid_blocks);
}
```
